# Optimizing an MI355X kernel written in HIP

```python
import jax, jax.numpy as jnp
from jax import lax
import numpy as np

D_MODEL = 2048
BATCH = 8
SEQ = 2048
DEPTH = 1

GM_WIDTH = 2048
CHUNK = 128
GM_GROUPS = 16
GM_GROUP_DIM = GM_WIDTH // GM_GROUPS
MLA_HEADS = 16
Q_LORA = 512
KV_LORA = 256
QK_NOPE = 128
QK_ROPE = 64
V_HEAD = 128
ROPE_THETA = 10000.0
Q_BLOCK = 128
D_FF = 5632
CONV_W = 3
EPS = 1e-6
N_MOD = 6
IN_SIZES = (GM_WIDTH, GM_WIDTH, Q_LORA, KV_LORA, QK_ROPE, D_MODEL, D_MODEL)
IN_COLS = sum(IN_SIZES)
IN_SPLITS = tuple(int(s) for s in np.cumsum(IN_SIZES)[:-1])

kernel_name = "hybrid_gmlp_mla_convffn_block"


def rmsnorm(x, g):
    xf = x.astype(jnp.float32)
    y = xf * lax.rsqrt(jnp.mean(xf * xf, axis=-1, keepdims=True) + EPS)
    return (y * g.astype(jnp.float32)).astype(x.dtype)


def layernorm(x, g, b):
    xf = x.astype(jnp.float32)
    mu = jnp.mean(xf, axis=-1, keepdims=True)
    var = jnp.mean(jnp.square(xf - mu), axis=-1, keepdims=True)
    y = (xf - mu) * lax.rsqrt(var + EPS)
    return (y * g.astype(jnp.float32) + b.astype(jnp.float32)).astype(x.dtype)


def rope_tables(positions, dtype):
    inv = ROPE_THETA ** (-jnp.arange(0, QK_ROPE, 2, dtype=jnp.float32) / QK_ROPE)
    ang = positions.astype(jnp.float32)[..., None] * inv
    return jnp.cos(ang).astype(dtype), jnp.sin(ang).astype(dtype)


def apply_rope(x, cos, sin):
    x1, x2 = jnp.split(x, 2, axis=-1)
    return jnp.concatenate([x1 * cos - x2 * sin, x2 * cos + x1 * sin], axis=-1)


def gmlp_spatial_gating(u, v, ln_g, ln_b, w_s, b_s):
    B, S, _ = v.shape
    v = layernorm(v, ln_g, ln_b)
    v = v.reshape(B, S // CHUNK, CHUNK, GM_GROUPS, GM_GROUP_DIM)
    mask = jnp.tril(jnp.ones((CHUNK, CHUNK), dtype=w_s.dtype))
    mixed = jnp.einsum('bnpgd,gqp->bnqgd', v, w_s * mask) + b_s.T[None, None, :, :, None]
    return u * mixed.reshape(B, S, GM_WIDTH)


def mla_attention(q_lat, kv_lat, k_pe, positions, q_norm_g, w_uq, kv_norm_g, w_ukv):
    B, S, _ = q_lat.shape
    q = (rmsnorm(q_lat, q_norm_g) @ w_uq).reshape(B, S, MLA_HEADS, QK_NOPE + QK_ROPE)
    kv = (rmsnorm(kv_lat, kv_norm_g) @ w_ukv).reshape(B, S, MLA_HEADS, QK_NOPE + V_HEAD)
    q_nope, q_pe = q[..., :QK_NOPE], q[..., QK_NOPE:]
    k_nope, v = kv[..., :QK_NOPE], kv[..., QK_NOPE:]
    cos, sin = rope_tables(positions, q.dtype)
    q_pe = apply_rope(q_pe, cos[:, :, None], sin[:, :, None])
    k_pe = apply_rope(k_pe, cos, sin)
    q = jnp.concatenate([q_nope, q_pe], axis=-1)
    k = jnp.concatenate([k_nope, jnp.broadcast_to(k_pe[:, :, None], (B, S, MLA_HEADS, QK_ROPE))], axis=-1)
    scale = (QK_NOPE + QK_ROPE) ** -0.5
    n_blocks = S // Q_BLOCK
    q_blocks = q.reshape(B, n_blocks, Q_BLOCK, MLA_HEADS, QK_NOPE + QK_ROPE).transpose(1, 0, 2, 3, 4)
    key_pos = jnp.arange(S)

    def attend(args):
        qb, i = args
        s = jnp.einsum('bqhd,bkhd->bhqk', qb, k).astype(jnp.float32) * scale
        q_pos = i * Q_BLOCK + jnp.arange(Q_BLOCK)
        causal = key_pos[None, :] <= q_pos[:, None]
        s = jnp.where(causal[None, None], s, -1e30)
        p = jax.nn.softmax(s, axis=-1).astype(v.dtype)
        return jnp.einsum('bhqk,bkhd->bqhd', p, v)

    o = lax.map(attend, (q_blocks, jnp.arange(n_blocks)))
    return o.transpose(1, 0, 2, 3, 4).reshape(B, S, MLA_HEADS * V_HEAD)


def causal_dwconv(h, w, b):
    S = h.shape[1]
    hp = jnp.pad(h, ((0, 0), (CONV_W - 1, 0), (0, 0)))
    return sum(w[k] * hp[:, k:k + S] for k in range(CONV_W)) + b


def setup_inputs(seed: int = 0) -> dict:
    key = jax.random.key(seed)
    ks = jax.random.split(key, 32)
    f32 = jnp.float32
    nrm = lambda k, shape, s: jax.random.normal(k, shape, f32) * s
    gain = lambda k, n: 1.0 + 0.02 * jax.random.normal(k, (n,), f32)
    offset = jax.random.randint(ks[2], (BATCH, 1), 0, 4096, dtype=jnp.int32)
    positions = (jnp.arange(SEQ, dtype=jnp.int32)[None, :] + offset).astype(jnp.int32)
    return {
        "x": nrm(ks[0], (BATCH, SEQ, D_MODEL), 1.0),
        "c": nrm(ks[1], (BATCH, D_MODEL), 1.0),
        "positions": positions,
        "w_ada": nrm(ks[3], (D_MODEL, N_MOD * D_MODEL), 0.5 * D_MODEL ** -0.5),
        "b_ada": nrm(ks[4], (N_MOD * D_MODEL,), 0.01),
        "pre_norm1_g": gain(ks[5], D_MODEL),
        "w_in": nrm(ks[6], (D_MODEL, IN_COLS), D_MODEL ** -0.5),
        "gm_ln_g": gain(ks[7], GM_WIDTH),
        "gm_ln_b": nrm(ks[8], (GM_WIDTH,), 0.01),
        "gm_w_s": nrm(ks[9], (GM_GROUPS, CHUNK, CHUNK), CHUNK ** -0.5),
        "gm_b_s": 1.0 + 0.02 * jax.random.normal(ks[10], (GM_GROUPS, CHUNK), f32),
        "w_branch_a": nrm(ks[11], (GM_WIDTH, D_MODEL), GM_WIDTH ** -0.5),
        "q_norm_g": gain(ks[12], Q_LORA),
        "w_uq": nrm(ks[13], (Q_LORA, MLA_HEADS * (QK_NOPE + QK_ROPE)), Q_LORA ** -0.5),
        "kv_norm_g": gain(ks[14], KV_LORA),
        "w_ukv": nrm(ks[15], (KV_LORA, MLA_HEADS * (QK_NOPE + V_HEAD)), KV_LORA ** -0.5),
        "w_branch_b": nrm(ks[16], (MLA_HEADS * V_HEAD, D_MODEL), (MLA_HEADS * V_HEAD) ** -0.5),
        "w_out": nrm(ks[17], (D_MODEL, D_MODEL), D_MODEL ** -0.5),
        "post_norm1_g": gain(ks[18], D_MODEL),
        "pre_norm2_g": gain(ks[19], D_MODEL),
        "w_up": nrm(ks[20], (D_MODEL, 2 * D_FF), D_MODEL ** -0.5),
        "conv_w": nrm(ks[21], (CONV_W, 2 * D_FF), CONV_W ** -0.5),
        "conv_b": nrm(ks[22], (2 * D_FF,), 0.01),
        "w_down": nrm(ks[23], (D_FF, D_MODEL), D_FF ** -0.5),
        "post_norm2_g": gain(ks[24], D_MODEL),
    }


def reference(x, c, positions, w_ada, b_ada, pre_norm1_g, w_in, gm_ln_g, gm_ln_b, gm_w_s, gm_b_s,
              w_branch_a, q_norm_g, w_uq, kv_norm_g, w_ukv, w_branch_b, w_out, post_norm1_g,
              pre_norm2_g, w_up, conv_w, conv_b, w_down, post_norm2_g):
    B = x.shape[0]
    mod = (jax.nn.silu(c) @ w_ada + b_ada).reshape(B, N_MOD, D_MODEL)
    shift1, scale1, gate1 = mod[:, None, 0], mod[:, None, 1], mod[:, None, 2]
    shift2, scale2, gate2 = mod[:, None, 3], mod[:, None, 4], mod[:, None, 5]

    for _ in range(DEPTH):
        h = rmsnorm(x, pre_norm1_g) * (1.0 + scale1) + shift1
        z = h @ w_in
        u, v, q_lat, kv_lat, k_pe, g_a, g_b = jnp.split(z, IN_SPLITS, axis=-1)
        y_a = gmlp_spatial_gating(jax.nn.gelu(u), jax.nn.gelu(v), gm_ln_g, gm_ln_b, gm_w_s, gm_b_s) @ w_branch_a
        y_b = mla_attention(q_lat, kv_lat, k_pe, positions, q_norm_g, w_uq, kv_norm_g, w_ukv) @ w_branch_b
        merged = jax.nn.sigmoid(g_a) * y_a + jax.nn.sigmoid(g_b) * y_b
        x = x + gate1 * rmsnorm(merged @ w_out, post_norm1_g)

        h = rmsnorm(x, pre_norm2_g) * (1.0 + scale2) + shift2
        up = causal_dwconv(h @ w_up, conv_w, conv_b)
        gate_h, val_h = jnp.split(up, 2, axis=-1)
        ffn = (jax.nn.silu(gate_h) * val_h) @ w_down
        x = x + gate2 * rmsnorm(ffn, post_norm2_g)
    return x
```

```cpp
#include <hip/hip_runtime.h>
#include <hip/hip_cooperative_groups.h>
#include <cstdio>
#include <cstdint>
#include <cmath>
namespace cg = cooperative_groups;
#ifndef MK_LAUNCHES
#define MK_LAUNCHES 1
#endif
namespace pg8 {
#define PG8_LAS __attribute__((address_space(3)))
typedef unsigned short bf16_t;
typedef short bf16x8 __attribute__((ext_vector_type(8)));
typedef float f32x4 __attribute__((ext_vector_type(4)));
typedef unsigned u32x4 __attribute__((ext_vector_type(4)));
constexpr int BM = 256, BK = 64, HALF = 128, HTB = HALF * BK * 2  , STAGE_BYTES = 8 * HTB, NXCD = 8, WGM = 8;

__host__ __device__ __forceinline__ int lds_byte(int r, int c) { const int st = (r >> 4) * 2 + (c >> 5), rr = r & 15, cc = c & 31, ob = rr * 64 + cc * 2; return st * 1024 + (ob ^ (((ob >> 9) & 1) << 5)); }
__host__ __device__ __forceinline__ void stage_rc(int b, int& R, int& C) { const int st = b / 1024, sb = b % 1024, swz = sb ^ (((sb >> 9) & 1) << 5); R = (st >> 1) * 16 + swz / 64; C = (st & 1) * 32 + (swz % 64) / 2; }
__host__ __device__ __forceinline__ int perm32(int rho) { const int n = rho >> 4, i = rho & 15; return 8 * (i >> 2) + 4 * n + (i & 3); }

struct Unit { int pm, pn; };
struct Gemm { const bf16_t* A; const bf16_t* Bt; int M, N, K, lda, kpairA; };

struct StaticOrder {
    int nM, nN, nwg, G, c;
    __host__ __device__ void init(int M, int N, int G_, int c_) { nM = M / BM; nN = N / BM; nwg = nM * nN; G = G_; c = c_; }
    __host__ __device__ bool next(int i, Unit& u) const {
        const long L = (long)i * G + c; if (L >= nwg) return false;
        int wgid = (int)L; { const int q = nwg / NXCD, r = nwg % NXCD, xcd = wgid % NXCD, off = wgid / NXCD; wgid = (xcd < r ? xcd * (q + 1) : r * (q + 1) + (xcd - r) * q) + off; }
        const int nig = WGM * nN, gid = wgid / nig, fm = gid * WGM, gsz = (nM - fm) < WGM ? (nM - fm) : WGM;
        u.pm = fm + ((wgid % nig) % gsz); u.pn = (wgid % nig) / gsz; return true;
    }
    __device__ __forceinline__ void a_ready(const Unit&) const {}
    __device__ __forceinline__ void done(const Unit&) const {}
};


typedef unsigned u32x2 __attribute__((ext_vector_type(2)));
__device__ __forceinline__ unsigned cvt_pk_bf16(float lo, float hi) { unsigned r; asm("v_cvt_pk_bf16_f32 %0, %1, %2" : "=v"(r) : "v"(lo), "v"(hi)); return r; }
__device__ __forceinline__ float bf_lo(unsigned w) { return __uint_as_float(w << 16); }
__device__ __forceinline__ float bf_hi(unsigned w) { return __uint_as_float(w & 0xffff0000u); }
__device__ __forceinline__ float gelu_tanh(float v) { const float t = v * (1.0f + 0.044715f * v * v); const float e = __builtin_amdgcn_exp2f(-2.3022081986f * t); return v * __builtin_amdgcn_rcpf(1.0f + e); }
__device__ __forceinline__ float sigmoid_f(float v) { return __builtin_amdgcn_rcpf(1.0f + __builtin_amdgcn_exp2f(-1.4426950409f * v)); }
__device__ __forceinline__ u32x4 pack8(f32x4 a, f32x4 b) { u32x4 w; w.x = cvt_pk_bf16(a[0], a[1]); w.y = cvt_pk_bf16(a[2], a[3]); w.z = cvt_pk_bf16(b[0], b[1]); w.w = cvt_pk_bf16(b[2], b[3]); return w; }

struct EpiIn {
    static constexpr bool PERM = true, AFTER_DRAIN = false;
    bf16_t *GU, *GV, *SGA, *SGB, *QL, *KVL, *KPE; float *STV, *STQ, *STKV; const float *COS, *SIN;
    __device__ __forceinline__ void operator()(const f32x4 (&acc)[2][2][4][2], const Unit& u, int wr, int wc, int fr, int fq) const {
        const int pn = u.pn, row0 = u.pm * BM + wr * 64 + fr, cw = wc * 32 + 8 * fq;
        if (pn >= 16 && pn < 19) {
            bf16_t* base = pn < 18 ? QL : KVL; const int ld = pn < 18 ? 512 : 256, ct = pn == 17 ? 256 : 0; float* st = pn < 18 ? STQ : STKV;
#pragma unroll
            for (int ai = 0; ai < 2; ++ai)
#pragma unroll
                for (int m = 0; m < 4; ++m) { const int row = row0 + ai * HALF + m * 16; float ss = 0.f;
#pragma unroll
                    for (int bj = 0; bj < 2; ++bj) { const u32x4 w = pack8(acc[ai][bj][m][0], acc[ai][bj][m][1]); *(u32x4*)(base + (size_t)row * ld + ct + cw + bj * HALF) = w;
                        ss += (bf_lo(w.x) * bf_lo(w.x) + bf_hi(w.x) * bf_hi(w.x)) + (bf_lo(w.y) * bf_lo(w.y) + bf_hi(w.y) * bf_hi(w.y)) + (bf_lo(w.z) * bf_lo(w.z) + bf_hi(w.z) * bf_hi(w.z)) + (bf_lo(w.w) * bf_lo(w.w) + bf_hi(w.w) * bf_hi(w.w)); }
                    ss += __shfl_xor(ss, 16); ss += __shfl_xor(ss, 32);
                    if (fq == 0) unsafeAtomicAdd(st + row, ss); }
        } else if (pn == 19) {
            if (wc < 2) { const int i0 = 4 * (4 * wc + fq);
#pragma unroll
                for (int ai = 0; ai < 2; ++ai)
#pragma unroll
                    for (int m = 0; m < 4; ++m) { const int row = row0 + ai * HALF + m * 16;
                        const size_t ti = ((size_t)((((row >> 5) * 2 + (i0 >> 4)) * 2 + ((i0 >> 3) & 1)) * 32 + (row & 31)) << 3) + (i0 & 7);
                        const f32x4 c = *(const f32x4*)(COS + ti), sn = *(const f32x4*)(SIN + ti), x1 = acc[ai][0][m][0], x2 = acc[ai][0][m][1];
                        const f32x4 o1 = x1 * c - x2 * sn, o2 = x2 * c + x1 * sn;
                        u32x2 w1, w2; w1.x = cvt_pk_bf16(o1[0], o1[1]); w1.y = cvt_pk_bf16(o1[2], o1[3]); w2.x = cvt_pk_bf16(o2[0], o2[1]); w2.y = cvt_pk_bf16(o2[2], o2[3]);
                        *(u32x2*)(KPE + (size_t)row * 64 + i0) = w1; *(u32x2*)(KPE + (size_t)row * 64 + 32 + i0) = w2; } }
        } else {
            bf16_t* base; int ct; bool sg;
            if (pn < 8) { base = GU; ct = pn * 256; sg = false; } else if (pn < 16) { base = GV; ct = (pn - 8) * 256; sg = false; }
            else if (pn < 28) { base = SGA; ct = (pn - 20) * 256; sg = true; } else { base = SGB; ct = (pn - 28) * 256; sg = true; }
            const bool stat = pn >= 8 && pn < 16;
#pragma unroll
            for (int ai = 0; ai < 2; ++ai)
#pragma unroll
                for (int m = 0; m < 4; ++m) { const int row = row0 + ai * HALF + m * 16; bf16_t* rowp = base + (size_t)row * 2048 + ct + cw; float s1 = 0.f, s2 = 0.f;
#pragma unroll
                    for (int bj = 0; bj < 2; ++bj) { f32x4 v0 = acc[ai][bj][m][0], v1 = acc[ai][bj][m][1];
                        if (sg) {
#pragma unroll
                            for (int j = 0; j < 4; ++j) { v0[j] = sigmoid_f(v0[j]); v1[j] = sigmoid_f(v1[j]); }
                        } else {
#pragma unroll
                            for (int j = 0; j < 4; ++j) { v0[j] = gelu_tanh(v0[j]); v1[j] = gelu_tanh(v1[j]); }
                        }
                        const u32x4 w = pack8(v0, v1); *(u32x4*)(rowp + bj * HALF) = w;
                        if (stat) { const float a0 = bf_lo(w.x), a1 = bf_hi(w.x), a2 = bf_lo(w.y), a3 = bf_hi(w.y), a4 = bf_lo(w.z), a5 = bf_hi(w.z), a6 = bf_lo(w.w), a7 = bf_hi(w.w);
                            s1 += ((a0 + a1) + (a2 + a3)) + ((a4 + a5) + (a6 + a7)); s2 += ((a0 * a0 + a1 * a1) + (a2 * a2 + a3 * a3)) + ((a4 * a4 + a5 * a5) + (a6 * a6 + a7 * a7)); } }
                    if (stat) { s1 += __shfl_xor(s1, 16); s1 += __shfl_xor(s1, 32); s2 += __shfl_xor(s2, 16); s2 += __shfl_xor(s2, 32);
                        if (fq == 0) { unsafeAtomicAdd(STV + 2 * row, s1); unsafeAtomicAdd(STV + 2 * row + 1, s2); } } }
        }
    }
};
struct EpiBf16 {
    static constexpr bool PERM = true, AFTER_DRAIN = false;
    bf16_t* O; int ld; float sc; const float* rowss; float invn;
    __device__ __forceinline__ void operator()(const f32x4 (&acc)[2][2][4][2], const Unit& u, int wr, int wc, int fr, int fq) const {
        const int row0 = u.pm * BM + wr * 64 + fr, c0 = u.pn * BM + wc * 32 + 8 * fq;
#pragma unroll
        for (int ai = 0; ai < 2; ++ai)
#pragma unroll
            for (int m = 0; m < 4; ++m) { const int row = row0 + ai * HALF + m * 16; bf16_t* rowp = O + (size_t)row * ld + c0;
                const float scr = rowss ? sc * (1.0f / sqrtf(rowss[row] * invn + 1e-6f)) : sc;
#pragma unroll
                for (int bj = 0; bj < 2; ++bj) *(u32x4*)(rowp + bj * HALF) = pack8(acc[ai][bj][m][0] * scr, acc[ai][bj][m][1] * scr); }
    }
};
struct EpiQ {
    static constexpr bool PERM = true, AFTER_DRAIN = false;
    bf16_t* Q; float sc; const float* rowss; float invn;
    __device__ __forceinline__ void operator()(const f32x4 (&acc)[2][2][4][2], const Unit& u, int wr, int wc, int fr, int fq) const {
        const int row0 = u.pm * BM + wr * 64 + fr, c0 = u.pn * BM + wc * 32 + 8 * fq;
#pragma unroll
        for (int ai = 0; ai < 2; ++ai)
#pragma unroll
            for (int m = 0; m < 4; ++m) { const int row = row0 + ai * HALF + m * 16;
                const float scr = sc * (1.0f / sqrtf(rowss[row] * invn + 1e-6f));
#pragma unroll
                for (int bj = 0; bj < 2; ++bj) { const int col = c0 + bj * HALF, h = col / 192, d = col - h * 192;
                    bf16_t* dst = Q + ((((size_t)((row >> 5) * 16 + h) * 12 + (d >> 4)) * 2 + ((d >> 3) & 1)) * 32 + (row & 31)) * 8;
                    *(u32x4*)dst = pack8(acc[ai][bj][m][0] * scr, acc[ai][bj][m][1] * scr); } }
    }
};
struct EpiKV {
    static constexpr bool PERM = true, AFTER_DRAIN = false;
    bf16_t *KN, *VT; const float* rowss;
    __device__ __forceinline__ void operator()(const f32x4 (&acc)[2][2][4][2], const Unit& u, int wr, int wc, int fr, int fq) const {
        const int h = u.pn, row0 = u.pm * BM + wr * 64 + fr, cw = wc * 32 + 8 * fq;
#pragma unroll
        for (int ai = 0; ai < 2; ++ai)
#pragma unroll
            for (int m = 0; m < 4; ++m) { const int row = row0 + ai * HALF + m * 16; const float scr = 1.0f / sqrtf(rowss[row] * (1.0f / 256.0f) + 1e-6f);
                *(u32x4*)(KN + (size_t)row * 2048 + h * 128 + cw) = pack8(acc[ai][0][m][0] * scr, acc[ai][0][m][1] * scr);
                *(u32x4*)(VT + (size_t)row * 2048 + h * 128 + cw) = pack8(acc[ai][1][m][0] * scr, acc[ai][1][m][1] * scr); }
    }
};
struct EpiMulInPlace {
    static constexpr bool PERM = true, AFTER_DRAIN = false;
    bf16_t* T;
    __device__ __forceinline__ void operator()(const f32x4 (&acc)[2][2][4][2], const Unit& u, int wr, int wc, int fr, int fq) const {
        const int row0 = u.pm * BM + wr * 64 + fr, c0 = u.pn * BM + wc * 32 + 8 * fq;
#pragma unroll
        for (int ai = 0; ai < 2; ++ai)
#pragma unroll
            for (int m = 0; m < 4; ++m) { bf16_t* rowp = T + (size_t)(row0 + ai * HALF + m * 16) * 2048 + c0;
#pragma unroll
                for (int bj = 0; bj < 2; ++bj) { const u32x4 g = *(const u32x4*)(rowp + bj * HALF); const f32x4 v0 = acc[ai][bj][m][0], v1 = acc[ai][bj][m][1];
                    const f32x4 o0 = {bf_lo(g.x) * v0[0], bf_hi(g.x) * v0[1], bf_lo(g.y) * v0[2], bf_hi(g.y) * v0[3]};
                    const f32x4 o1 = {bf_lo(g.z) * v1[0], bf_hi(g.z) * v1[1], bf_lo(g.w) * v1[2], bf_hi(g.w) * v1[3]};
                    *(u32x4*)(rowp + bj * HALF) = pack8(o0, o1); } }
    }
};
struct EpiMerge {
    static constexpr bool PERM = true, AFTER_DRAIN = false;
    bf16_t* T; const bf16_t* G;
    __device__ __forceinline__ void operator()(const f32x4 (&acc)[2][2][4][2], const Unit& u, int wr, int wc, int fr, int fq) const {
        const int row0 = u.pm * BM + wr * 64 + fr, c0 = u.pn * BM + wc * 32 + 8 * fq;
#pragma unroll
        for (int ai = 0; ai < 2; ++ai)
#pragma unroll
            for (int m = 0; m < 4; ++m) { const size_t off = (size_t)(row0 + ai * HALF + m * 16) * 2048 + c0;
#pragma unroll
                for (int bj = 0; bj < 2; ++bj) { const u32x4 t = *(const u32x4*)(T + off + bj * HALF); const u32x4 g = *(const u32x4*)(G + off + bj * HALF);
                    const f32x4 v0 = acc[ai][bj][m][0], v1 = acc[ai][bj][m][1];
                    const f32x4 o0 = {bf_lo(t.x) + bf_lo(g.x) * v0[0], bf_hi(t.x) + bf_hi(g.x) * v0[1], bf_lo(t.y) + bf_lo(g.y) * v0[2], bf_hi(t.y) + bf_hi(g.y) * v0[3]};
                    const f32x4 o1 = {bf_lo(t.z) + bf_lo(g.z) * v1[0], bf_hi(t.z) + bf_hi(g.z) * v1[1], bf_lo(t.w) + bf_lo(g.w) * v1[2], bf_hi(t.w) + bf_hi(g.w) * v1[3]};
                    *(u32x4*)(T + off + bj * HALF) = pack8(o0, o1); } }
    }
};
struct EpiUp {
    static constexpr bool PERM = true, AFTER_DRAIN = false;
    bf16_t *UP, *HALO;
    __device__ __forceinline__ void operator()(const f32x4 (&acc)[2][2][4][2], const Unit& u, int wr, int wc, int fr, int fq) const {
        const int row0 = u.pm * BM + wr * 64 + fr, c0 = u.pn * BM + wc * 32 + 8 * fq;
#pragma unroll
        for (int ai = 0; ai < 2; ++ai)
#pragma unroll
            for (int m = 0; m < 4; ++m) { const int row = row0 + ai * HALF + m * 16; bf16_t* rowp = UP + (size_t)row * 5632 + u.pn * HALF + wc * 32 + 8 * fq;
#pragma unroll
                for (int bj = 0; bj < 2; ++bj) { const u32x4 w = pack8(acc[ai][bj][m][0], acc[ai][bj][m][1]); __builtin_nontemporal_store(w, (u32x4*)(rowp + (size_t)bj * ((size_t)16384 * 5632)));
                    if (m == 3 && fr >= 14) *(u32x4*)(HALO + ((size_t)(row >> 6) * 2 + (fr - 14)) * 11264 + c0 + bj * HALF) = w; } }
    }
};
template <class Epi, class Sched, bool ALIGN_EPI = false, bool SP2 = false>
__device__ __forceinline__ void gemm_phase(PG8_LAS unsigned char* lds, const Gemm g, const Sched& S, const Epi& E, int wv) {
    int tid_; asm volatile("v_mbcnt_lo_u32_b32 %0, -1, 0\n\tv_mbcnt_hi_u32_b32 %0, -1, %0" : "=v"(tid_)); tid_ |= (wv << 6); const int tid = tid_, wid = __builtin_amdgcn_readfirstlane(tid >> 6), lane = tid & 63, wr = wid >> 2, wc = wid & 3, fr = lane & 15, fq = lane >> 4;
    const int K = g.K, nt = K / BK;
    unsigned voffA[2], voffB[2];
#pragma unroll
    for (int i = 0; i < 2; ++i) { int R, C; stage_rc(tid * 16 + i * 8192, R, C); const int Rb = Epi::PERM ? ((R & ~31) + perm32(R & 31)) : R;
        voffA[i] = (unsigned)(R * g.lda + C) * 2u; voffB[i] = (unsigned)(Rb * K + C) * 2u; }
    const size_t kstep = (size_t)(BK * 2);
    const size_t hstepA = (size_t)HALF * g.lda * 2, hstepB = (size_t)HALF * K * 2;
    const size_t tstepA = 2 * hstepA, tstepB = 2 * hstepB; const size_t kpairA = (size_t)g.kpairA;
    const unsigned ldsw = (unsigned)wid * 1024u;
    const int aoff = lds_byte(wr * 64 + fr, fq * 8), boff = lds_byte(wc * 32 + fr, fq * 8);
#define PG8_SA(b, h) (((b) * 2 + (h)) * HTB)
#define PG8_SB(b, h) ((4 + (b) * 2 + (h)) * HTB)
#define PG8_STAGE(bufoff, gbase, voff) do { _Pragma("unroll") for (int _i = 0; _i < 2; ++_i) \
        __builtin_amdgcn_global_load_lds((const unsigned*)((const char*)(gbase) + (voff)[_i]), (PG8_LAS unsigned*)(lds + (bufoff) + ldsw + _i * 8192), 16, 0, 0); } while (0)
#define PG8_LDA(dst, b, h) do { _Pragma("unroll") for (int m = 0; m < 4; ++m) _Pragma("unroll") for (int k = 0; k < 2; ++k) dst[m][k] = *(const PG8_LAS bf16x8*)(lds + PG8_SA(b, h) + aoff + m * 2048 + k * 1024); } while (0)
#define PG8_LDB(dst, b, h) do { _Pragma("unroll") for (int n = 0; n < 2; ++n) _Pragma("unroll") for (int k = 0; k < 2; ++k) dst[n][k] = *(const PG8_LAS bf16x8*)(lds + PG8_SB(b, h) + boff + n * 2048 + k * 1024); } while (0)
#define PG8_MMA(ai, bj, At, Bt) do { __builtin_amdgcn_s_setprio(1); _Pragma("unroll") for (int m = 0; m < 4; ++m) _Pragma("unroll") for (int n = 0; n < 2; ++n) _Pragma("unroll") for (int k = 0; k < 2; ++k) \
        acc[ai][bj][m][n] = __builtin_amdgcn_mfma_f32_16x16x32_bf16(Bt[n][k], At[m][k], acc[ai][bj][m][n], 0, 0, 0); __builtin_amdgcn_s_setprio(0); } while (0)
#define PG8_WAIT_V(n) asm volatile("s_waitcnt vmcnt(" #n ")" ::: "memory")
#define PG8_WAIT_L(n) asm volatile("s_waitcnt lgkmcnt(" #n ")" ::: "memory")
#define PG8_BAR __builtin_amdgcn_s_barrier()
#define PG8_SCHED __builtin_amdgcn_sched_barrier(0)
    Unit cur, nxt; int ui = 0;
    if (!S.next(0, cur)) return;
    f32x4 acc[2][2][4][2];
#pragma unroll
    for (int a = 0; a < 2; ++a)
#pragma unroll
        for (int b = 0; b < 2; ++b)
#pragma unroll
            for (int m = 0; m < 4; ++m)
#pragma unroll
                for (int n = 0; n < 2; ++n) acc[a][b][m][n] = (f32x4){0.f, 0.f, 0.f, 0.f};
    bf16x8 At[4][2], B0[2][2], B1[2][2];
    const char* cA = (const char*)g.A + (size_t)cur.pm * tstepA; const char* cB = (const char*)g.Bt + (size_t)cur.pn * tstepB;
    S.a_ready(cur);
    if constexpr (SP2) {
        PG8_STAGE(PG8_SB(0, 0), cB, voffB); PG8_STAGE(PG8_SB(0, 1), cB + hstepB, voffB); PG8_STAGE(PG8_SA(0, 0), cA, voffA); PG8_STAGE(PG8_SA(0, 1), cA + hstepA, voffA);
        if (wr == 1) PG8_BAR;
        PG8_WAIT_V(2); PG8_BAR;
        PG8_STAGE(PG8_SB(1, 0), cB + kstep, voffB); PG8_STAGE(PG8_SA(1, 0), cA + kstep, voffA); PG8_STAGE(PG8_SB(1, 1), cB + hstepB + kstep, voffB);
        PG8_WAIT_V(6); PG8_BAR;
    } else {
        PG8_STAGE(PG8_SB(0, 0), cB, voffB); PG8_STAGE(PG8_SA(0, 0), cA, voffA); PG8_STAGE(PG8_SB(0, 1), cB + hstepB, voffB); PG8_STAGE(PG8_SA(0, 1), cA + hstepA, voffA);
        if (wr == 1) PG8_BAR;
        PG8_WAIT_V(4); PG8_BAR;
        PG8_STAGE(PG8_SB(1, 0), cB + kstep, voffB); PG8_STAGE(PG8_SA(1, 0), cA + kstep, voffA); PG8_STAGE(PG8_SB(1, 1), cB + hstepB + kstep, voffB);
        PG8_WAIT_V(6); PG8_BAR;
    }
    for (;;) {
        const bool has_next = S.next(ui + 1, nxt);
        const char* nA = has_next ? (const char*)g.A + (size_t)nxt.pm * tstepA : cA; const char* nB = has_next ? (const char*)g.Bt + (size_t)nxt.pn * tstepB : cB;
        for (int t = 0; t < nt; t += 2) {
            const bool last = (t == nt - 2);
            const char* a1 = cA + (size_t)(t >> 1) * kpairA + kstep;
            const char* a2 = last ? nA : cA + (size_t)((t >> 1) + 1) * kpairA; const char* b2 = last ? nB : cB + (size_t)(t + 2) * kstep;
            const char* a3 = a2 + kstep; const char* b3 = b2 + kstep;
            if (last && has_next) S.a_ready(nxt);
            if constexpr (SP2) {
            PG8_LDB(B0, 0, 0); PG8_LDB(B1, 0, 1); PG8_SCHED; PG8_LDA(At, 0, 0); PG8_STAGE(PG8_SA(1, 1), a1 + hstepA, voffA);
            PG8_WAIT_V(8); PG8_WAIT_L(0); PG8_BAR; PG8_MMA(0, 0, At, B0); PG8_MMA(0, 1, At, B1); PG8_BAR; PG8_SCHED;
            PG8_LDA(At, 0, 1); PG8_STAGE(PG8_SB(0, 0), b2, voffB); PG8_STAGE(PG8_SB(0, 1), b2 + hstepB, voffB); PG8_STAGE(PG8_SA(0, 0), a2, voffA);
            PG8_WAIT_V(8); PG8_WAIT_L(0); PG8_BAR; PG8_MMA(1, 0, At, B0); PG8_MMA(1, 1, At, B1); PG8_BAR; PG8_SCHED;
            PG8_LDB(B0, 1, 0); PG8_LDB(B1, 1, 1); PG8_SCHED; PG8_LDA(At, 1, 0); PG8_STAGE(PG8_SA(0, 1), a2 + hstepA, voffA);
            PG8_WAIT_V(8); PG8_WAIT_L(0); PG8_BAR; PG8_MMA(0, 0, At, B0); PG8_MMA(0, 1, At, B1); PG8_BAR; PG8_SCHED;
            PG8_LDA(At, 1, 1); PG8_STAGE(PG8_SB(1, 0), b3, voffB); PG8_STAGE(PG8_SB(1, 1), b3 + hstepB, voffB); PG8_STAGE(PG8_SA(1, 0), a3, voffA);
            PG8_WAIT_V(8); PG8_WAIT_L(0); PG8_BAR; PG8_MMA(1, 0, At, B0); PG8_MMA(1, 1, At, B1); PG8_BAR; PG8_SCHED;
            } else {
            PG8_LDB(B0, 0, 0); PG8_SCHED; PG8_LDA(At, 0, 0); PG8_STAGE(PG8_SA(1, 1), a1 + hstepA, voffA);
            PG8_WAIT_L(8); PG8_BAR; PG8_WAIT_L(0); PG8_MMA(0, 0, At, B0); PG8_BAR; PG8_SCHED;
            PG8_LDB(B1, 0, 1); PG8_STAGE(PG8_SB(0, 0), b2, voffB);
            PG8_BAR; PG8_WAIT_L(0); PG8_MMA(0, 1, At, B1); PG8_BAR;
            PG8_LDA(At, 0, 1); PG8_STAGE(PG8_SA(0, 0), a2, voffA);
            PG8_BAR; PG8_WAIT_L(0); PG8_MMA(1, 0, At, B0); PG8_BAR; PG8_SCHED;
            PG8_STAGE(PG8_SB(0, 1), b2 + hstepB, voffB);
            PG8_WAIT_V(6); PG8_BAR; PG8_MMA(1, 1, At, B1); PG8_BAR;
            PG8_LDB(B0, 1, 0); PG8_SCHED; PG8_LDA(At, 1, 0); PG8_STAGE(PG8_SA(0, 1), a2 + hstepA, voffA);
            PG8_WAIT_L(8); PG8_BAR; PG8_WAIT_L(0); PG8_MMA(0, 0, At, B0); PG8_BAR; PG8_SCHED;
            PG8_LDB(B1, 1, 1); PG8_STAGE(PG8_SB(1, 0), b3, voffB);
            PG8_BAR; PG8_WAIT_L(0); PG8_MMA(0, 1, At, B1); PG8_BAR;
            PG8_LDA(At, 1, 1); PG8_STAGE(PG8_SA(1, 0), a3, voffA);
            PG8_BAR; PG8_WAIT_L(0); PG8_MMA(1, 0, At, B0); PG8_BAR; PG8_SCHED;
            PG8_STAGE(PG8_SB(1, 1), b3 + hstepB, voffB);
            PG8_WAIT_V(6); PG8_BAR; PG8_MMA(1, 1, At, B1); PG8_BAR;
            }
        }
        if constexpr (ALIGN_EPI) { if (wr == 0) PG8_BAR; }
        if constexpr (!Epi::AFTER_DRAIN) { E(acc, cur, wr, wc, fr, fq); S.done(cur); }
        if (!has_next) break;
#pragma unroll
        for (int a = 0; a < 2; ++a)
#pragma unroll
            for (int b = 0; b < 2; ++b)
#pragma unroll
                for (int m = 0; m < 4; ++m)
#pragma unroll
                    for (int n = 0; n < 2; ++n) acc[a][b][m][n] = (f32x4){0.f, 0.f, 0.f, 0.f};
        cur = nxt; cA = nA; cB = nB; ++ui;
        if constexpr (ALIGN_EPI) { if (wr == 1) PG8_BAR; }
    }
    PG8_WAIT_V(0);
    if constexpr (!ALIGN_EPI) { if (wr == 0) PG8_BAR; }
    PG8_BAR;
    if constexpr (Epi::AFTER_DRAIN) { E.fused(acc, cur, wr, wc, fr, fq, lds, wid, lane); S.done(cur); }
#undef PG8_SA
#undef PG8_SB
#undef PG8_STAGE
#undef PG8_LDA
#undef PG8_LDB
#undef PG8_MMA
#undef PG8_WAIT_V
#undef PG8_WAIT_L
#undef PG8_BAR
#undef PG8_SCHED
}
}

using pg8::bf16_t; using pg8::bf16x8; using pg8::f32x4; using pg8::u32x4; using pg8::u32x2; using pg8::cvt_pk_bf16; using pg8::bf_lo; using pg8::bf_hi; using pg8::pack8;
#define LAS __attribute__((address_space(3)))
typedef float f32x16 __attribute__((ext_vector_type(16)));
constexpr int M_ = 16384, D_ = 2048, S_ = 2048;
constexpr float EPS_ = 1e-6f;
constexpr size_t MiB = (size_t)1 << 20;
constexpr size_t WS_MODP = 1 * MiB, WS_COS = 4 * MiB, WS_SIN = 6 * MiB, WS_KPE = 8 * MiB;
constexpr size_t WS_WIN = 10 * MiB, WS_QN = 10 * MiB, WS_KVN = 26 * MiB, WS_WUP = 10 * MiB;
constexpr size_t WS_WA = 54 * MiB, WS_WB = 62 * MiB, WS_WOUT = 70 * MiB, WS_WUQ = 78 * MiB, WS_WUKV = 81 * MiB, WS_WDOWN = 54 * MiB;
constexpr size_t WS_D = 83 * MiB, WS_E = 147 * MiB, WS_F = 211 * MiB, WS_G = 275 * MiB, WS_KN = 339 * MiB, WS_VT = 403 * MiB;
constexpr size_t WS_UP = 147 * MiB, WS_HALO = 499 * MiB;
constexpr size_t WS_QL = 467 * MiB, WS_KVL = 483 * MiB, WS_STAT = 491 * MiB;
constexpr int LDS_BYTES = 147456;
constexpr float QSCALE = 0.07216878364870322f * 1.4426950408889634f;

struct Args { const void* in[25]; float* out; unsigned char* ws; float inv[32]; int ph_lo, ph_hi; };

__device__ __forceinline__ float wave_sum(float v) {
#pragma unroll
    for (int o = 1; o < 64; o <<= 1) v += __shfl_xor(v, o);
    return v;
}
#define LDS_WAIT() asm volatile("s_waitcnt lgkmcnt(0)" ::: "memory")

__device__ __forceinline__ void transpose_matrix(const float* W, int K, int N, bf16_t* WT, int mode, LAS float* scr, int lane, int gw, int NGW, int& rot, const float* gain = nullptr) {
    const int nblk = N / 64, nitems = (K / 64) * nblk;
    LAS unsigned* s32 = (LAS unsigned*)scr; LAS unsigned short* s16 = (LAS unsigned short*)scr;
    int start = gw - (rot % NGW); if (start < 0) start += NGW;
    const int r = lane >> 4, col4 = (lane & 15) * 4, c = lane & 7;
    for (int it = start; it < nitems; it += NGW) {
        const int kb = it / nblk, nb = it % nblk, k0 = 64 * kb, n0 = 64 * nb;
        int rd = n0;
        if (mode == 1) rd = n0 < 4928 ? n0 : n0 + 192;
        else if (mode == 2) { const int isv = n0 >= 5632 ? 1 : 0; const int cc = n0 - isv * 5632; rd = 256 * (cc >> 7) + 128 * isv + (cc & 127); }
        f32x4 v[16];
        const float* wp = W + (size_t)(k0 + r) * N + n0 + col4;
#pragma unroll
        for (int i = 0; i < 16; ++i) v[i] = __builtin_nontemporal_load((const f32x4*)(wp + (size_t)(4 * i) * N));
#pragma unroll
        for (int i = 0; i < 16; ++i) { const int row = 4 * i + r; if (gain) v[i] = v[i] * gain[k0 + row];
            s32[row * 33 + (col4 >> 1)] = cvt_pk_bf16(v[i][0], v[i][1]); s32[row * 33 + (col4 >> 1) + 1] = cvt_pk_bf16(v[i][2], v[i][3]); }
        const bool kpe_blk = (mode == 1 && n0 == 4864);
        LDS_WAIT();
#pragma unroll
        for (int j = 0; j < 8; ++j) { const int n = (lane >> 3) + 8 * j; const LAS unsigned short* p = s16 + (8 * c) * 66 + n;
            u32x4 o; o.x = (unsigned)p[0 * 66] | ((unsigned)p[1 * 66] << 16); o.y = (unsigned)p[2 * 66] | ((unsigned)p[3 * 66] << 16);
            o.z = (unsigned)p[4 * 66] | ((unsigned)p[5 * 66] << 16); o.w = (unsigned)p[6 * 66] | ((unsigned)p[7 * 66] << 16);
            const int rdn = kpe_blk ? rd + 8 * ((n & 31) >> 2) + (n & 3) + ((n >> 5) << 2) : rd + n;
            if (mode == 0 && K != 5632) __builtin_nontemporal_store(o, (u32x4*)(WT + (size_t)rdn * K + k0 + 8 * c)); else *(u32x4*)(WT + (size_t)rdn * K + k0 + 8 * c) = o; }
        LDS_WAIT();
    }
    rot += nitems;
}

__device__ __forceinline__ f32x4 modv(const float* MODP, const float* b_ada, int b, int j, int c) {
    f32x4 v = *(const f32x4*)(b_ada + j * 2048 + c);
#pragma unroll
    for (int kc = 0; kc < 8; ++kc) v += *(const f32x4*)(MODP + (size_t)(kc * 8 + b) * 12288 + j * 2048 + c);
    return v;
}

__device__ __forceinline__ void phase0(const Args& a, LAS unsigned char* lds, int G, int wv) {
    int tid_; asm volatile("v_mbcnt_lo_u32_b32 %0, -1, 0\n\tv_mbcnt_hi_u32_b32 %0, -1, %0" : "=v"(tid_)); tid_ |= (wv << 6); const int tid = tid_, lane = tid & 63, wave = __builtin_amdgcn_readfirstlane(tid >> 6);
    const int gw = blockIdx.x * 8 + wave, NGW = G * 8;
    LAS float* SC = (LAS float*)lds;
    LAS float* scr = (LAS float*)(lds + 65536 + wave * 8448);
    const float* cin = (const float*)a.in[1];
    for (int idx = tid; idx < 8 * 2048; idx += 512) { const int b = idx >> 11, k = idx & 2047; const float v = cin[idx]; SC[k * 8 + b] = v / (1.0f + __expf(-v)); }
    __syncthreads();
    {
        const float* w_ada = (const float*)a.in[3]; float* MODP = (float*)(a.ws + WS_MODP);
        for (int it = gw; it < 384 * 5; it += NGW) {
            if (it % 5) continue;
            const int item = it / 5, nch = item % 48, kch = item / 48, n0 = nch * 256 + lane * 4;
            f32x4 acc[8];
#pragma unroll
            for (int b = 0; b < 8; ++b) acc[b] = (f32x4){0.f, 0.f, 0.f, 0.f};
            const float* wp = w_ada + (size_t)(kch * 256) * 12288 + n0;
#pragma unroll 8
            for (int k = 0; k < 256; ++k) {
                const f32x4 w = __builtin_nontemporal_load((const f32x4*)(wp + (size_t)k * 12288));
                const f32x4 s0 = *(const LAS f32x4*)(SC + (kch * 256 + k) * 8), s1 = *(const LAS f32x4*)(SC + (kch * 256 + k) * 8 + 4);
                acc[0] += w * s0[0]; acc[1] += w * s0[1]; acc[2] += w * s0[2]; acc[3] += w * s0[3];
                acc[4] += w * s1[0]; acc[5] += w * s1[1]; acc[6] += w * s1[2]; acc[7] += w * s1[3];
            }
#pragma unroll
            for (int b = 0; b < 8; ++b) *(f32x4*)(MODP + (size_t)(kch * 8 + b) * 12288 + n0) = acc[b];
        }
    }
    {
        const int* pos = (const int*)a.in[2]; float* COS = (float*)(a.ws + WS_COS); float* SIN = (float*)(a.ws + WS_SIN);
        for (int idx = blockIdx.x * 512 + tid; idx < M_ * 32; idx += G * 512) {
            const int row = idx >> 5, i = idx & 31;
            const float ang = (float)pos[row] * a.inv[i];
            const double turns = (double)ang * 0.15915494309189535; const float fr = (float)(turns - __builtin_rint(turns));
            const int nidx = (((((row >> 5) * 2 + (i >> 4)) * 2 + ((i >> 3) & 1)) * 32 + (row & 31)) << 3) + (i & 7);
            COS[nidx] = __builtin_amdgcn_cosf(fr); SIN[nidx] = __builtin_amdgcn_sinf(fr);
        }
    }
    int rot = 0, tgw = gw, TNGW = NGW; bool conv = true;
    if (NGW == 2048) { const int nmb = (gw + 4) / 5 < 384 ? (gw + 4) / 5 : 384; conv = !((gw % 5 == 0) && (gw / 5 < 384)); tgw = gw - nmb; TNGW = 2048 - 384; }
    if (conv) {
    transpose_matrix((const float*)a.in[6], 2048, 9024, (bf16_t*)(a.ws + WS_WIN), 1, scr, lane, tgw, TNGW, rot);
    transpose_matrix((const float*)a.in[11], 2048, 2048, (bf16_t*)(a.ws + WS_WA), 0, scr, lane, tgw, TNGW, rot);
    transpose_matrix((const float*)a.in[16], 2048, 2048, (bf16_t*)(a.ws + WS_WB), 0, scr, lane, tgw, TNGW, rot);
    transpose_matrix((const float*)a.in[17], 2048, 2048, (bf16_t*)(a.ws + WS_WOUT), 0, scr, lane, tgw, TNGW, rot);
    transpose_matrix((const float*)a.in[13], 512, 3072, (bf16_t*)(a.ws + WS_WUQ), 0, scr, lane, tgw, TNGW, rot, (const float*)a.in[12]);
    transpose_matrix((const float*)a.in[15], 256, 4096, (bf16_t*)(a.ws + WS_WUKV), 0, scr, lane, tgw, TNGW, rot, (const float*)a.in[14]);
    }
    { u32x4* z = (u32x4*)(a.ws + WS_STAT); const u32x4 zz = {0u, 0u, 0u, 0u};
      for (int idx = blockIdx.x * 512 + tid; idx < 4 * M_ * 4 / 16; idx += G * 512) z[idx] = zz; }
    { u32x4* z = (u32x4*)((bf16_t*)(a.ws + WS_WIN) + (size_t)4928 * 2048); const u32x4 zz = {0u, 0u, 0u, 0u};
      for (int idx = blockIdx.x * 512 + tid; idx < 192 * 2048 / 8; idx += G * 512) z[idx] = zz; }
}

__device__ __forceinline__ void phase1(const Args& a, LAS unsigned char* lds, int G, int wv) {
    int tid_; asm volatile("v_mbcnt_lo_u32_b32 %0, -1, 0\n\tv_mbcnt_hi_u32_b32 %0, -1, %0" : "=v"(tid_)); tid_ |= (wv << 6); const int tid = tid_, lane = tid & 63, wave = __builtin_amdgcn_readfirstlane(tid >> 6);
    const float* x = (const float*)a.in[0]; const float* b_ada = (const float*)a.in[4]; const float* g1 = (const float*)a.in[5];
    const float* MODP = (const float*)(a.ws + WS_MODP); bf16_t* H1 = (bf16_t*)a.out;
    LAS f32x4* A1 = (LAS f32x4*)lds; LAS f32x4* B1 = (LAS f32x4*)(lds + 8192);
    for (int r0 = blockIdx.x * 64; r0 < M_; r0 += G * 64) {
        const int b = r0 >> 11;
        __syncthreads();
        { const int c = tid * 4; const f32x4 sc = modv(MODP, b_ada, b, 1, c), sh = modv(MODP, b_ada, b, 0, c), g = *(const f32x4*)(g1 + c);
          A1[tid] = g * (sc + 1.0f); B1[tid] = sh; }
        __syncthreads();
        _Pragma("unroll 1") for (int rr = 0; rr < 8; ++rr) {
            const int row = r0 + wave * 8 + rr; const f32x4* xr = (const f32x4*)(x + (size_t)row * 2048);
            f32x4 v[8]; float ss = 0.f;
#pragma unroll
            for (int j = 0; j < 8; ++j) { v[j] = __builtin_nontemporal_load(&xr[lane + 64 * j]); ss += (v[j][0] * v[j][0] + v[j][1] * v[j][1]) + (v[j][2] * v[j][2] + v[j][3] * v[j][3]); }
            const float rstd = 1.0f / sqrtf(wave_sum(ss) * (1.0f / 2048.0f) + EPS_);
            u32x2* o = (u32x2*)(H1 + (size_t)row * 2048);
#pragma unroll
            for (int j = 0; j < 8; ++j) { const f32x4 h = v[j] * rstd * A1[lane + 64 * j] + B1[lane + 64 * j]; u32x2 w; w.x = cvt_pk_bf16(h[0], h[1]); w.y = cvt_pk_bf16(h[2], h[3]); o[lane + 64 * j] = w; }
        }
    }
}

__device__ __forceinline__ void mix_phase(const Args& a, LAS unsigned char* lds, int G, int wv, size_t aa_out = WS_D) {
    int tid_; asm volatile("v_mbcnt_lo_u32_b32 %0, -1, 0\n\tv_mbcnt_hi_u32_b32 %0, -1, %0" : "=v"(tid_)); tid_ |= (wv << 6); const int tid = tid_, lane = tid & 63, w = __builtin_amdgcn_readfirstlane(tid >> 6);
    const float* Ws = (const float*)a.in[9]; const float* bs = (const float*)a.in[10];
    const bf16_t* VN = (const bf16_t*)(a.ws + WS_E); bf16_t* GU = (bf16_t*)(a.ws + WS_D);
    const float* STV = (const float*)(a.ws + WS_STAT); const float* lng = (const float*)a.in[7]; const float* lnb = (const float*)a.in[8];
    LAS unsigned char* Wl = lds; LAS unsigned char* Vl = lds + 34816;
    int gl = -1;
    for (int it = blockIdx.x; it < 2048; it += G) {
        const int g = it & 15, bc = it >> 4, r0 = (bc >> 4) * 2048 + (bc & 15) * 128, c0 = g * 128;
        __syncthreads();
        if (g != gl) { gl = g;
#pragma unroll
            for (int i = 0; i < 8; ++i) { const int idx4 = tid + 512 * i, q = idx4 >> 5, p4 = (idx4 & 31) * 4; f32x4 wv = *(const f32x4*)(Ws + (size_t)g * 16384 + q * 128 + p4);
#pragma unroll
                for (int j = 0; j < 4; ++j) if (p4 + j > q) wv[j] = 0.f;
                u32x2 o; o.x = cvt_pk_bf16(wv[0], wv[1]); o.y = cvt_pk_bf16(wv[2], wv[3]); *(LAS u32x2*)(Wl + q * 272 + p4 * 2) = o; } }
#pragma unroll
        for (int i = 0; i < 4; ++i) { const int id = tid + 512 * i, p = id >> 4, dc = id & 15; const u32x4 vr = *(const u32x4*)(VN + (size_t)(r0 + p) * 2048 + c0 + dc * 8);
            const float mean = STV[2 * (r0 + p)] * (1.0f / 2048.0f), rstd = 1.0f / sqrtf(fmaxf(STV[2 * (r0 + p) + 1] * (1.0f / 2048.0f) - mean * mean, 0.f) + EPS_);
            const f32x4 g0 = *(const f32x4*)(lng + c0 + dc * 8), g1 = *(const f32x4*)(lng + c0 + dc * 8 + 4), b0 = *(const f32x4*)(lnb + c0 + dc * 8), b1 = *(const f32x4*)(lnb + c0 + dc * 8 + 4);
            const f32x4 x0 = {bf_lo(vr.x), bf_hi(vr.x), bf_lo(vr.y), bf_hi(vr.y)}, x1 = {bf_lo(vr.z), bf_hi(vr.z), bf_lo(vr.w), bf_hi(vr.w)};
            const u32x4 v = pack8((x0 - mean) * rstd * g0 + b0, (x1 - mean) * rstd * g1 + b1);
            LAS unsigned short* vd = (LAS unsigned short*)(Vl + (dc * 8) * 272 + p * 2);
            vd[0 * 136] = (unsigned short)(v.x & 0xffffu); vd[1 * 136] = (unsigned short)(v.x >> 16); vd[2 * 136] = (unsigned short)(v.y & 0xffffu); vd[3 * 136] = (unsigned short)(v.y >> 16);
            vd[4 * 136] = (unsigned short)(v.z & 0xffffu); vd[5 * 136] = (unsigned short)(v.z >> 16); vd[6 * 136] = (unsigned short)(v.w & 0xffffu); vd[7 * 136] = (unsigned short)(v.w >> 16); }
        __syncthreads();
        f32x4 acc[8];
#pragma unroll
        for (int mb = 0; mb < 8; ++mb) acc[mb] = (f32x4){0.f, 0.f, 0.f, 0.f};
        const int nks = (w >> 1) + 1;
        for (int ks = 0; ks < nks; ++ks) {
            const bf16x8 bw = *(const LAS bf16x8*)(Wl + (16 * w + (lane & 15)) * 272 + ks * 64 + (lane >> 4) * 16);
#pragma unroll
            for (int mb = 0; mb < 8; ++mb) { const bf16x8 av = *(const LAS bf16x8*)(Vl + (16 * mb + (lane & 15)) * 272 + ks * 64 + (lane >> 4) * 16);
                acc[mb] = __builtin_amdgcn_mfma_f32_16x16x32_bf16(av, bw, acc[mb], 0, 0, 0); }
        }
        const int q = lane & 15, quad = lane >> 4, row = r0 + 16 * w + q; const float bias = bs[g * 128 + 16 * w + q];
#pragma unroll
        for (int mb = 0; mb < 8; ++mb) { u32x2* p = (u32x2*)(GU + (size_t)row * 2048 + c0 + 16 * mb + 4 * quad); const u32x2 uu = *p; p = (u32x2*)((bf16_t*)(a.ws + aa_out) + (size_t)row * 2048 + c0 + 16 * mb + 4 * quad);
            u32x2 o; o.x = cvt_pk_bf16(bf_lo(uu.x) * (acc[mb][0] + bias), bf_hi(uu.x) * (acc[mb][1] + bias)); o.y = cvt_pk_bf16(bf_lo(uu.y) * (acc[mb][2] + bias), bf_hi(uu.y) * (acc[mb][3] + bias)); *p = o; }
    }
    __syncthreads();
}

__device__ __forceinline__ void att_glds16(const void* gsrc, unsigned lds_dst) { unsigned keep;
    asm volatile("s_mov_b32 %0, m0\n\ts_mov_b32 m0, %2\n\ts_nop 0\n\tglobal_load_lds_dwordx4 %1, off\n\ts_mov_b32 m0, %0" : "=&s"(keep) : "v"(gsrc), "s"(lds_dst) : "memory"); }
constexpr int AK_PITCH = 400, AV_PITCH = 320, AK_BYTES = 64 * AK_PITCH, AV_BYTES = 64 * AV_PITCH;
typedef short att_v4i16 __attribute__((ext_vector_type(4)));
__device__ __forceinline__ void attn_unit(int bh, int qb, const bf16_t* Q, const bf16_t* KN, const bf16_t* KPE, const bf16_t* VT, const float* COS, const float* SIN, bf16_t* O, LAS unsigned char* lds, int wv) {
    int tid_; asm volatile("v_mbcnt_lo_u32_b32 %0, -1, 0\n\tv_mbcnt_hi_u32_b32 %0, -1, %0" : "=v"(tid_)); tid_ |= (wv << 6); const int tid = tid_, lane = tid & 63, wid = __builtin_amdgcn_readfirstlane(tid >> 6), r32 = lane & 31, hi = lane >> 5;
    const int b = bh >> 4, h = bh & 15, q0 = qb * 256;
    const size_t rowbase = (size_t)b * 2048;
    const int qrow = q0 + 32 * wid + r32;
    const unsigned lds0 = (unsigned)(uintptr_t)lds;
    const bf16_t* csrc[6]; int cstep[6]; unsigned cdst[6];
#pragma unroll
    for (int i = 0; i < 6; ++i) { int id = wid + 8 * i; if (id > 44) id = 44;
        if (id < 25) { const int c = id * 1024 + 16 * lane, row = c / AK_PITCH, col = c % AK_PITCH;
            if (col < 256) { csrc[i] = KN + (rowbase + row) * 2048 + h * 128 + (col >> 1); cstep[i] = 64 * 2048; }
            else if (col < 384) { csrc[i] = KPE + (rowbase + row) * 64 + ((col - 256) >> 1); cstep[i] = 64 * 64; }
            else { csrc[i] = KN + (rowbase + row) * 2048 + h * 128; cstep[i] = 64 * 2048; }
            cdst[i] = (unsigned)(id * 1024); }
        else { const int c = (id - 25) * 1024 + 16 * lane, row = c / AV_PITCH, col = c % AV_PITCH;
            csrc[i] = VT + (rowbase + row) * 2048 + h * 128 + (col < 256 ? (col >> 1) : 0); cstep[i] = 64 * 2048;
            cdst[i] = (unsigned)(3 * AK_BYTES + (id - 25) * 1024); } }
    const int NT = (q0 + 256) / 64;
#define ATT_ISSUE(tt, slot) do { _Pragma("unroll") for (int i_ = 0; i_ < 6; ++i_) { \
        const unsigned dst_ = lds0 + cdst[i_] + (unsigned)(slot) * (unsigned)((wid + 8 * i_ < 25) ? AK_BYTES : AV_BYTES); \
        att_glds16(csrc[i_] + (size_t)(tt) * cstep[i_], (unsigned)__builtin_amdgcn_readfirstlane(dst_)); } } while (0)
    ATT_ISSUE(0, 0); ATT_ISSUE(1, 1);
    bf16x8 qf[12];
    { const size_t rb = (rowbase + q0 + 32 * wid) >> 5;
      const bf16_t* qp = Q + ((((rb * 16 + h) * 12) * 2 + hi) * 32 + r32) * 8;
#pragma unroll
      for (int d0 = 0; d0 < 12; ++d0) qf[d0] = *(const bf16x8*)(qp + (size_t)d0 * 512);
#pragma unroll
      for (int e = 0; e < 2; ++e) { const size_t ti = (((rb * 2 + e) * 2 + hi) * 32 + r32) * 8; const float* cp = COS + ti; const float* sp = SIN + ti;
          const f32x4 c0 = *(const f32x4*)cp, c1 = *(const f32x4*)(cp + 4), s0 = *(const f32x4*)sp, s1 = *(const f32x4*)(sp + 4);
          const u32x4 x1 = __builtin_bit_cast(u32x4, qf[8 + e]), x2 = __builtin_bit_cast(u32x4, qf[10 + e]); u32x4 n1, n2;
#define ROPE2(W1, W2, O1, O2, CA, SA, CB, SB) { const float a1 = bf_lo(W1), a2 = bf_lo(W2), b1 = bf_hi(W1), b2 = bf_hi(W2); \
              O1 = cvt_pk_bf16(a1 * (CA) - a2 * (SA), b1 * (CB) - b2 * (SB)); O2 = cvt_pk_bf16(a2 * (CA) + a1 * (SA), b2 * (CB) + b1 * (SB)); }
          ROPE2(x1.x, x2.x, n1.x, n2.x, c0[0], s0[0], c0[1], s0[1]); ROPE2(x1.y, x2.y, n1.y, n2.y, c0[2], s0[2], c0[3], s0[3]);
          ROPE2(x1.z, x2.z, n1.z, n2.z, c1[0], s1[0], c1[1], s1[1]); ROPE2(x1.w, x2.w, n1.w, n2.w, c1[2], s1[2], c1[3], s1[3]);
#undef ROPE2
          qf[8 + e] = __builtin_bit_cast(bf16x8, n1); qf[10 + e] = __builtin_bit_cast(bf16x8, n2); } }
    asm volatile("s_waitcnt vmcnt(0)\n\ts_barrier" ::: "memory");
    f32x16 o[4];
#pragma unroll
    for (int d0 = 0; d0 < 4; ++d0)
#pragma unroll
        for (int r = 0; r < 16; ++r) o[d0][r] = 0.f;
    float m_run = -1e30f, l_run = 0.f;
    int s0i = 0, s1i = 1, s2 = 2;
    for (int t = 0; t < NT; ++t) {
        const bool more2 = t + 2 < NT;
        if (more2) ATT_ISSUE(t + 2, s2);
        const int buf = s0i;
        if (64 * t <= q0 + 32 * wid + 31) {
            const LAS unsigned char* kb = lds + buf * AK_BYTES + r32 * AK_PITCH + hi * 16;
            f32x16 s0, s1;
#pragma unroll
            for (int r = 0; r < 16; ++r) { s0[r] = 0.f; s1[r] = 0.f; }
#pragma unroll
            for (int d0 = 0; d0 < 12; ++d0) { const bf16x8 k0 = *(const LAS bf16x8*)(kb + d0 * 32), k1 = *(const LAS bf16x8*)(kb + 32 * AK_PITCH + d0 * 32);
                s0 = __builtin_amdgcn_mfma_f32_32x32x16_bf16(k0, qf[d0], s0, 0, 0, 0); s1 = __builtin_amdgcn_mfma_f32_32x32x16_bf16(k1, qf[d0], s1, 0, 0, 0); }
            if (t >= NT - 4) {
                const int kv0 = 64 * t + 4 * hi;
#pragma unroll
                for (int r = 0; r < 16; ++r) { const int kv = kv0 + (r & 3) + 8 * (r >> 2); if (kv > qrow) s0[r] = -1e30f; if (kv + 32 > qrow) s1[r] = -1e30f; }
            }
            float mx = s0[0];
#pragma unroll
            for (int r = 1; r < 16; ++r) mx = fmaxf(mx, s0[r]);
#pragma unroll
            for (int r = 0; r < 16; ++r) mx = fmaxf(mx, s1[r]);
            mx = fmaxf(mx, __shfl_xor(mx, 32));
            const bool grow = mx > m_run + 6.0f;
            if (__builtin_amdgcn_ballot_w64(grow) != 0ull) {
                const float m_new = grow ? mx : m_run, alpha = __builtin_amdgcn_exp2f(m_run - m_new); m_run = m_new; l_run *= alpha;
#pragma unroll
                for (int d0 = 0; d0 < 4; ++d0)
#pragma unroll
                    for (int r = 0; r < 16; ++r) o[d0][r] *= alpha;
            }
            float ls = 0.f;
#pragma unroll
            for (int r = 0; r < 16; ++r) { s0[r] = __builtin_amdgcn_exp2f(s0[r] - m_run); s1[r] = __builtin_amdgcn_exp2f(s1[r] - m_run); ls += s0[r] + s1[r]; }
            l_run += ls;
            bf16x8 pf[4];
            { u32x4 w;
              w.x = cvt_pk_bf16(s0[0], s0[1]); w.y = cvt_pk_bf16(s0[2], s0[3]); w.z = cvt_pk_bf16(s0[4], s0[5]); w.w = cvt_pk_bf16(s0[6], s0[7]); pf[0] = __builtin_bit_cast(bf16x8, w);
              w.x = cvt_pk_bf16(s0[8], s0[9]); w.y = cvt_pk_bf16(s0[10], s0[11]); w.z = cvt_pk_bf16(s0[12], s0[13]); w.w = cvt_pk_bf16(s0[14], s0[15]); pf[1] = __builtin_bit_cast(bf16x8, w);
              w.x = cvt_pk_bf16(s1[0], s1[1]); w.y = cvt_pk_bf16(s1[2], s1[3]); w.z = cvt_pk_bf16(s1[4], s1[5]); w.w = cvt_pk_bf16(s1[6], s1[7]); pf[2] = __builtin_bit_cast(bf16x8, w);
              w.x = cvt_pk_bf16(s1[8], s1[9]); w.y = cvt_pk_bf16(s1[10], s1[11]); w.z = cvt_pk_bf16(s1[12], s1[13]); w.w = cvt_pk_bf16(s1[14], s1[15]); pf[3] = __builtin_bit_cast(bf16x8, w); }
            const LAS unsigned char* vb = lds + 3 * AK_BYTES + buf * AV_BYTES + (4 * hi + ((lane & 15) >> 2)) * AV_PITCH + (16 * ((lane >> 4) & 1) + 4 * (lane & 3)) * 2;
#pragma unroll
            for (int d0 = 0; d0 < 4; ++d0)
#pragma unroll
                for (int ks = 0; ks < 4; ++ks) {
                    const att_v4i16 lo4 = __builtin_amdgcn_ds_read_tr16_b64_v4i16((LAS att_v4i16*)(vb + ks * 16 * AV_PITCH + d0 * 64));
                    const att_v4i16 hi4 = __builtin_amdgcn_ds_read_tr16_b64_v4i16((LAS att_v4i16*)(vb + (ks * 16 + 8) * AV_PITCH + d0 * 64));
                    const bf16x8 vf = {lo4[0], lo4[1], lo4[2], lo4[3], hi4[0], hi4[1], hi4[2], hi4[3]};
                    o[d0] = __builtin_amdgcn_mfma_f32_32x32x16_bf16(vf, pf[ks], o[d0], 0, 0, 0); }
        }
        { const int tmp_ = s0i; s0i = s1i; s1i = s2; s2 = tmp_; }
        if (more2) asm volatile("s_waitcnt vmcnt(6) lgkmcnt(0)\n\ts_barrier" ::: "memory");
        else asm volatile("s_waitcnt vmcnt(0) lgkmcnt(0)\n\ts_barrier" ::: "memory");
    }
#undef ATT_ISSUE
    const float l = l_run + __shfl_xor(l_run, 32), il = 1.0f / l;
    { LAS unsigned char* stg = lds + wid * 8704;
#pragma unroll
      for (int d0 = 0; d0 < 4; ++d0)
#pragma unroll
          for (int rq = 0; rq < 4; ++rq) { u32x2 w; w.x = cvt_pk_bf16(o[d0][4 * rq] * il, o[d0][4 * rq + 1] * il); w.y = cvt_pk_bf16(o[d0][4 * rq + 2] * il, o[d0][4 * rq + 3] * il);
              *(LAS u32x2*)(stg + r32 * 272 + (32 * d0 + 8 * rq + 4 * hi) * 2) = w; }
      asm volatile("s_waitcnt lgkmcnt(0)" ::: "memory");
      bf16_t* ob = O + (rowbase + q0 + 32 * wid) * 2048 + h * 128;
#pragma unroll
      for (int i = 0; i < 8; ++i) { const int row = 4 * i + (lane >> 4), ch = lane & 15; const u32x4 v = *(const LAS u32x4*)(stg + row * 272 + ch * 16); *(u32x4*)(ob + (size_t)row * 2048 + ch * 8) = v; }
      asm volatile("s_waitcnt lgkmcnt(0)\n\ts_barrier" ::: "memory"); }
}
__device__ __forceinline__ void attn_phase(const Args& a, LAS unsigned char* lds, int G, int wv) {
    const bf16_t* Q = (const bf16_t*)a.out; const bf16_t* KN = (const bf16_t*)(a.ws + WS_KN); const bf16_t* KPE = (const bf16_t*)(a.ws + WS_KPE); const bf16_t* VT = (const bf16_t*)(a.ws + WS_VT);
    const float* COS = (const float*)(a.ws + WS_COS); const float* SIN = (const float*)(a.ws + WS_SIN); bf16_t* O = (bf16_t*)(a.ws + WS_E);
    for (int L = blockIdx.x; L < 1024; L += G) {
        const int i = L >> 8, c = L & 255, bh = c >> 1, s = c & 1;
        const int qb = (i == 0) ? (s ? 6 : 7) : (i == 1) ? (s ? 1 : 0) : (i == 2) ? (s ? 4 : 5) : (s ? 3 : 2);
        attn_unit(bh, qb, Q, KN, KPE, VT, COS, SIN, O, lds, wv);
    }
    __syncthreads();
}

__device__ __forceinline__ void phase8(const Args& a, LAS unsigned char* lds, int G, int wv, size_t h2_out = WS_D) {
    int tid_; asm volatile("v_mbcnt_lo_u32_b32 %0, -1, 0\n\tv_mbcnt_hi_u32_b32 %0, -1, %0" : "=v"(tid_)); tid_ |= (wv << 6); const int tid = tid_, lane = tid & 63, wave = __builtin_amdgcn_readfirstlane(tid >> 6);
    const float* x = (const float*)a.in[0]; const float* b_ada = (const float*)a.in[4]; const float* gp1 = (const float*)a.in[18]; const float* g2 = (const float*)a.in[19];
    const float* MODP = (const float*)(a.ws + WS_MODP); const bf16_t* Y = (const bf16_t*)a.out;
    LAS float* G1 = (LAS float*)lds; LAS float* A2 = (LAS float*)(lds + 8192); LAS float* B2 = (LAS float*)(lds + 16384);
    for (int r0 = blockIdx.x * 64; r0 < M_; r0 += G * 64) {
        const int b = r0 >> 11;
        __syncthreads();
        { const int c = tid * 4; *(LAS f32x4*)(G1 + c) = modv(MODP, b_ada, b, 2, c) * *(const f32x4*)(gp1 + c);
          *(LAS f32x4*)(A2 + c) = *(const f32x4*)(g2 + c) * (modv(MODP, b_ada, b, 4, c) + 1.0f); *(LAS f32x4*)(B2 + c) = modv(MODP, b_ada, b, 3, c); }
        __syncthreads();
        _Pragma("unroll 1") for (int rr = 0; rr < 8; ++rr) {
            const int row = r0 + wave * 8 + rr; const u32x4* yp = (const u32x4*)(Y + (size_t)row * 4096); const float* xr = x + (size_t)row * 2048;
            float f[4][8]; float ss = 0.f;
#pragma unroll
            for (int j = 0; j < 4; ++j) { const u32x4 w = yp[lane + 64 * j];
                f[j][0] = bf_lo(w.x); f[j][1] = bf_hi(w.x); f[j][2] = bf_lo(w.y); f[j][3] = bf_hi(w.y); f[j][4] = bf_lo(w.z); f[j][5] = bf_hi(w.z); f[j][6] = bf_lo(w.w); f[j][7] = bf_hi(w.w);
#pragma unroll
                for (int e = 0; e < 8; ++e) ss += f[j][e] * f[j][e]; }
            const float ry = 1.0f / sqrtf(wave_sum(ss) * (1.0f / 2048.0f) + EPS_);
            float s2 = 0.f;
#pragma unroll
            for (int j = 0; j < 4; ++j) { const int c = 8 * (lane + 64 * j);
                const f32x4 xa = __builtin_nontemporal_load((const f32x4*)(xr + c)), xb = __builtin_nontemporal_load((const f32x4*)(xr + c + 4)), ga = *(const LAS f32x4*)(G1 + c), gb = *(const LAS f32x4*)(G1 + c + 4);
                f32x4 ya = {f[j][0], f[j][1], f[j][2], f[j][3]}, yb = {f[j][4], f[j][5], f[j][6], f[j][7]};
                ya = xa + ga * ya * ry; yb = xb + gb * yb * ry;
#pragma unroll
                for (int e = 0; e < 4; ++e) { f[j][e] = ya[e]; f[j][4 + e] = yb[e]; s2 += ya[e] * ya[e] + yb[e] * yb[e]; } }
            const float rx = 1.0f / sqrtf(wave_sum(s2) * (1.0f / 2048.0f) + EPS_);
#pragma unroll
            for (int j = 0; j < 4; ++j) { const int c = 8 * (lane + 64 * j);
                const f32x4 aa = *(const LAS f32x4*)(A2 + c), ab = *(const LAS f32x4*)(A2 + c + 4), ba = *(const LAS f32x4*)(B2 + c), bb = *(const LAS f32x4*)(B2 + c + 4);
                const f32x4 ha = {f[j][0] * rx * aa[0] + ba[0], f[j][1] * rx * aa[1] + ba[1], f[j][2] * rx * aa[2] + ba[2], f[j][3] * rx * aa[3] + ba[3]};
                const f32x4 hb = {f[j][4] * rx * ab[0] + bb[0], f[j][5] * rx * ab[1] + bb[1], f[j][6] * rx * ab[2] + bb[2], f[j][7] * rx * ab[3] + bb[3]};
                ((u32x4*)((bf16_t*)(a.ws + h2_out) + (size_t)row * 2048))[lane + 64 * j] = pack8(ha, hb); }
        }
    }
    __syncthreads();
    LAS float* scr = (LAS float*)(lds + 32768 + wave * 8448);
    const int gw = blockIdx.x * 8 + wave, NGW = G * 8; int rot = 0;
    transpose_matrix((const float*)a.in[20], 2048, 11264, (bf16_t*)(a.ws + WS_WUP), 2, scr, lane, gw, NGW, rot);
    transpose_matrix((const float*)a.in[23], 5632, 2048, (bf16_t*)(a.ws + WS_WDOWN), 0, scr, lane, gw, NGW, rot);
}

__device__ __forceinline__ f32x4 bf4(u32x2 w) { return (f32x4){bf_lo(w.x), bf_hi(w.x), bf_lo(w.y), bf_hi(w.y)}; }
__device__ __forceinline__ void phase10(const Args& a, int G, int wv, bool dummy = false) {
    int tid_; asm volatile("v_mbcnt_lo_u32_b32 %0, -1, 0\n\tv_mbcnt_hi_u32_b32 %0, -1, %0" : "=v"(tid_)); tid_ |= (wv << 6); const int tid = tid_, lane = tid & 63, wave = __builtin_amdgcn_readfirstlane(tid >> 6);
    const int gw = blockIdx.x * 8 + wave, NGW = G * 8;
    const float* cw = (const float*)a.in[21]; const float* cb = (const float*)a.in[22];
    bf16_t* UP = (bf16_t*)(a.ws + WS_UP); const bf16_t* HALO = (const bf16_t*)(a.ws + WS_HALO);
    for (int it = gw; it < 256 * 22; it += NGW) {
        const int rs = it / 22, cs = it % 22, row0 = rs * 64, pn = 2 * cs + (lane >> 5), j = (lane & 31) * 4, col = 256 * pn + j, ch = 128 * pn + j; constexpr size_t VPL = (size_t)16384 * 5632;
        const f32x4 wg0 = *(const f32x4*)(cw + ch), wg1 = *(const f32x4*)(cw + 11264 + ch), wg2 = *(const f32x4*)(cw + 22528 + ch), bg = *(const f32x4*)(cb + ch);
        const f32x4 wv0 = *(const f32x4*)(cw + 5632 + ch), wv1 = *(const f32x4*)(cw + 11264 + 5632 + ch), wv2 = *(const f32x4*)(cw + 22528 + 5632 + ch), bv = *(const f32x4*)(cb + 5632 + ch);
        f32x4 gm2 = {0.f, 0.f, 0.f, 0.f}, gm1 = gm2, vm2 = gm2, vm1 = gm2;
        if (row0 & 2047) { const bf16_t* hp = HALO + (size_t)(rs - 1) * 2 * 11264 + col;
            gm2 = bf4(*(const u32x2*)hp); gm1 = bf4(*(const u32x2*)(hp + 11264)); vm2 = bf4(*(const u32x2*)(hp + 128)); vm1 = bf4(*(const u32x2*)(hp + 11264 + 128)); }
        bf16_t* up = UP + (size_t)row0 * 5632 + ch;
        for (int t0 = 0; t0 < 64; t0 += 8) {
            u32x2 gr[8], vr[8];
#pragma unroll
            for (int t = 0; t < 8; ++t) { gr[t] = __builtin_nontemporal_load((const u32x2*)(up + (size_t)(t0 + t) * 5632)); vr[t] = __builtin_nontemporal_load((const u32x2*)(up + VPL + (size_t)(t0 + t) * 5632)); }
#pragma unroll
            for (int t = 0; t < 8; ++t) { const f32x4 gc = bf4(gr[t]), vc = bf4(vr[t]);
                const f32x4 gg = wg0 * gm2 + wg1 * gm1 + wg2 * gc + bg, vv = wv0 * vm2 + wv1 * vm1 + wv2 * vc + bv;
                f32x4 o;
#pragma unroll
                for (int e = 0; e < 4; ++e) o[e] = gg[e] * pg8::sigmoid_f(gg[e]) * vv[e];
                u32x2 w; w.x = cvt_pk_bf16(o[0], o[1]); w.y = cvt_pk_bf16(o[2], o[3]);
                if (dummy) *(u32x2*)((bf16_t*)(a.ws + WS_D) + ((((size_t)(row0 + t0 + t)) * 5632 + ch) & (size_t)0x1ffffff)) = w; else *(u32x2*)(up + (size_t)(t0 + t) * 5632) = w;
                gm2 = gm1; gm1 = gc; vm2 = vm1; vm1 = vc; }
        }
    }
}

__device__ __forceinline__ void phase12(const Args& a, LAS unsigned char* lds, int G, int wv, float* xout_base = nullptr) {
    int tid_; asm volatile("v_mbcnt_lo_u32_b32 %0, -1, 0\n\tv_mbcnt_hi_u32_b32 %0, -1, %0" : "=v"(tid_)); tid_ |= (wv << 6); const int tid = tid_, lane = tid & 63, wave = __builtin_amdgcn_readfirstlane(tid >> 6);
    (void)xout_base;
    const float* x = (const float*)a.in[0]; const float* b_ada = (const float*)a.in[4]; const float* gp1 = (const float*)a.in[18]; const float* gp2 = (const float*)a.in[24];
    const float* MODP = (const float*)(a.ws + WS_MODP); const bf16_t* F = (const bf16_t*)(a.ws + WS_D); const bf16_t* Y = (const bf16_t*)a.out; float* OUT = a.out;
    LAS float* G1 = (LAS float*)lds; LAS float* G2 = (LAS float*)(lds + 8192);
    for (int r0 = blockIdx.x * 64; r0 < M_; r0 += G * 64) {
        const int b = r0 >> 11;
        __syncthreads();
        { const int c = tid * 4; *(LAS f32x4*)(G1 + c) = modv(MODP, b_ada, b, 2, c) * *(const f32x4*)(gp1 + c); *(LAS f32x4*)(G2 + c) = modv(MODP, b_ada, b, 5, c) * *(const f32x4*)(gp2 + c); }
        __syncthreads();
        _Pragma("unroll 1") for (int rr = 0; rr < 8; ++rr) {
            const int row = r0 + wave * 8 + rr; const u32x4* fp = (const u32x4*)(F + (size_t)row * 2048); const u32x4* yp = (const u32x4*)(Y + (size_t)row * 4096);
            const float* xr = x + (size_t)row * 2048; float* xo = OUT + (size_t)row * 2048;
            u32x4 yw[4], fw[4]; float ssy = 0.f, ssf = 0.f;
#pragma unroll
            for (int j = 0; j < 4; ++j) { yw[j] = yp[lane + 64 * j]; fw[j] = __builtin_nontemporal_load(&fp[lane + 64 * j]); }
#pragma unroll
            for (int j = 0; j < 4; ++j) {
                const float y0 = bf_lo(yw[j].x), y1 = bf_hi(yw[j].x), y2 = bf_lo(yw[j].y), y3 = bf_hi(yw[j].y), y4 = bf_lo(yw[j].z), y5 = bf_hi(yw[j].z), y6 = bf_lo(yw[j].w), y7 = bf_hi(yw[j].w);
                ssy += ((y0 * y0 + y1 * y1) + (y2 * y2 + y3 * y3)) + ((y4 * y4 + y5 * y5) + (y6 * y6 + y7 * y7));
                const float f0 = bf_lo(fw[j].x), f1 = bf_hi(fw[j].x), f2 = bf_lo(fw[j].y), f3 = bf_hi(fw[j].y), f4 = bf_lo(fw[j].z), f5 = bf_hi(fw[j].z), f6 = bf_lo(fw[j].w), f7 = bf_hi(fw[j].w);
                ssf += ((f0 * f0 + f1 * f1) + (f2 * f2 + f3 * f3)) + ((f4 * f4 + f5 * f5) + (f6 * f6 + f7 * f7)); }
            const float ry = 1.0f / sqrtf(wave_sum(ssy) * (1.0f / 2048.0f) + EPS_), rf = 1.0f / sqrtf(wave_sum(ssf) * (1.0f / 2048.0f) + EPS_);
#pragma unroll
            for (int j = 0; j < 4; ++j) { const int c = 8 * (lane + 64 * j);
                const f32x4 xa = __builtin_nontemporal_load((const f32x4*)(xr + c)), xb = __builtin_nontemporal_load((const f32x4*)(xr + c + 4));
                const f32x4 g1a = *(const LAS f32x4*)(G1 + c), g1b = *(const LAS f32x4*)(G1 + c + 4), g2a = *(const LAS f32x4*)(G2 + c), g2b = *(const LAS f32x4*)(G2 + c + 4);
                const f32x4 ya = {bf_lo(yw[j].x), bf_hi(yw[j].x), bf_lo(yw[j].y), bf_hi(yw[j].y)}, yb = {bf_lo(yw[j].z), bf_hi(yw[j].z), bf_lo(yw[j].w), bf_hi(yw[j].w)};
                const f32x4 fa = {bf_lo(fw[j].x), bf_hi(fw[j].x), bf_lo(fw[j].y), bf_hi(fw[j].y)}, fb = {bf_lo(fw[j].z), bf_hi(fw[j].z), bf_lo(fw[j].w), bf_hi(fw[j].w)};
                const f32x4 x1a = xa + g1a * ya * ry, x1b = xb + g1b * yb * ry;
                *(f32x4*)(xo + c) = x1a + g2a * fa * rf; *(f32x4*)(xo + c + 4) = x1b + g2b * fb * rf; }
        }
    }
}

#define XB_TMO      128
#define XB_XCNT(j)  (256  + 64 * (j))
#define XB_XSUB(j)  (1280 + 64 * (j))
#define XB_XGEN(j)  (2304 + 64 * (j))
#define XB_TOP      3328
#define XB_TOPGEN   3392
#define XCD_BAR_WORDS 3456
#define XB_SPIN_CAP (1u << 22)
__device__ __forceinline__ unsigned xb_ld(unsigned* p)              { return __hip_atomic_load(p, __ATOMIC_RELAXED, __HIP_MEMORY_SCOPE_AGENT); }
__device__ __forceinline__ unsigned xb_add(unsigned* p, unsigned v) { return __hip_atomic_fetch_add(p, v, __ATOMIC_RELAXED, __HIP_MEMORY_SCOPE_AGENT); }
__device__ __forceinline__ unsigned xb_xcc_id() { return (unsigned)__builtin_amdgcn_s_getreg((3 << 11) | 20) & 0xFu; }
#define XB_SPIN(cond, bar) do { unsigned _sp = 0; while (cond) { __builtin_amdgcn_s_sleep(1); \
    if ((++_sp & 255u) == 0u) { if (xb_ld(&(bar)[XB_TMO])) break; if (_sp > XB_SPIN_CAP) { atomicAdd(&(bar)[XB_TMO], 1u); break; } } } } while (0)
__device__ __forceinline__ void xcd_barrier_complete(unsigned* bar, unsigned x, unsigned G, unsigned& nloc, unsigned& nx) {
    unsigned sum, cnt, mine, sp = 0u;
    for (;;) {
        sum = 0u; cnt = 0u; mine = 0u;
#pragma unroll
        for (unsigned j = 0; j < 16; ++j) { const unsigned c = xb_ld(&bar[XB_XCNT(j)]); sum += c; cnt += (c > 0u) ? 1u : 0u; mine = (j == x) ? c : mine; }
        if (sum == G) break;
        __builtin_amdgcn_s_sleep(1);
        if ((++sp & 255u) == 0u) { if (xb_ld(&bar[XB_TMO])) break; if (sp > XB_SPIN_CAP) { atomicAdd(&bar[XB_TMO], 1u); break; } }
    }
    nloc = mine > 0u ? mine : 1u; nx = cnt > 0u ? cnt : 1u;
}
__device__ __forceinline__ void grid_barrier(unsigned* bar, unsigned x, volatile LAS unsigned* st, unsigned G, int wv) {
    asm volatile("s_waitcnt vmcnt(0) lgkmcnt(0)" ::: "memory");
    __syncthreads();
    int lane; asm volatile("v_mbcnt_lo_u32_b32 %0, -1, 0\n\tv_mbcnt_hi_u32_b32 %0, -1, %0" : "=v"(lane));
    if (wv == 0 && lane == 0) {
        __builtin_amdgcn_s_waitcnt(0);
        unsigned nloc = st[0], nx = st[1];
        if (nloc == 0u) { xcd_barrier_complete(bar, x, G, nloc, nx); st[0] = nloc; st[1] = nx; }
        const unsigned old = xb_add(&bar[XB_XSUB(x)], 1u);
        const unsigned gen = old / nloc;
        if (old + 1u == (gen + 1u) * nloc) {
            __builtin_amdgcn_fence(__ATOMIC_RELEASE, "agent");
            asm volatile("s_waitcnt vmcnt(0)" ::: "memory");
            const unsigned og = xb_add(&bar[XB_TOP], 1u);
            const unsigned tg = og / nx;
            if (og + 1u == (tg + 1u) * nx) xb_add(&bar[XB_TOPGEN], 1u);
            else XB_SPIN(xb_ld(&bar[XB_TOPGEN]) == tg, bar);
            __builtin_amdgcn_fence(__ATOMIC_ACQUIRE, "agent");
            xb_add(&bar[XB_XGEN(x)], 1u);
            asm volatile("s_waitcnt vmcnt(0)" ::: "memory");
        } else {
            XB_SPIN(xb_ld(&bar[XB_XGEN(x)]) == gen, bar);
            __builtin_amdgcn_fence(__ATOMIC_ACQUIRE, "agent");
            asm volatile("s_waitcnt vmcnt(0)" ::: "memory");
        }
    }
    __syncthreads();
}
template <class Epi> __device__ __forceinline__ void run_gemm(LAS unsigned char* lds, const bf16_t* A, const bf16_t* Bt, int N, int K, int lda, int kpairA, const Epi& E, int G, int wv) {
    pg8::Gemm g{A, Bt, M_, N, K, lda, kpairA}; pg8::StaticOrder S; S.init(M_, N, G, (int)blockIdx.x);
    pg8::gemm_phase<Epi, pg8::StaticOrder, true, true>(lds, g, S, E, wv);
}
constexpr int NPHASE = 13;
__global__ void __launch_bounds__(512) fwd_kernel(Args a) {
    extern __shared__ __attribute__((aligned(16))) unsigned char lds_raw[];
    LAS unsigned char* lds = (LAS unsigned char*)lds_raw;
    cg::grid_group grid = cg::this_grid();
    const int G = gridDim.x, lo = a.ph_lo, hi = a.ph_hi, wv = __builtin_amdgcn_readfirstlane((int)threadIdx.x >> 6);
    unsigned char* ws = a.ws;
#ifndef REPEAT_MASK
#define REPEAT_MASK 0
#endif
#define REP(k) ((REPEAT_MASK >> (k)) & 1)
#ifndef PH_MASK
#define PH_MASK 0x1fff
#endif
#define IN(k) (lo <= (k) && (k) < hi && ((PH_MASK >> (k)) & 1))
#define SEAM(k) do { if (IN(k) && IN((k) + 1)) { grid_barrier((unsigned*)ws, xcc, bst, (unsigned)G, wv); } } while (0)
    volatile LAS unsigned* bst = (volatile LAS unsigned*)(lds + LDS_BYTES - 16);
    const unsigned xcc = xb_xcc_id();
    if (threadIdx.x == 0) { bst[0] = 0u; bst[1] = 0u; (void)xb_add(&((unsigned*)ws)[XB_XCNT(xcc)], 1u); }
    __syncthreads();
    if (lo < 0) grid.sync();
    if (IN(0)) for (int rep_ = 0; rep_ <= REP(0); ++rep_) { __syncthreads(); phase0(a, lds, G, wv); }
    SEAM(0);
    if (IN(1)) for (int rep_ = 0; rep_ <= REP(1); ++rep_) { __syncthreads(); phase1(a, lds, G, wv); }
    SEAM(1);
    if (IN(2)) for (int rep_ = 0; rep_ <= REP(2); ++rep_) { __syncthreads(); pg8::EpiIn E{(bf16_t*)(ws + WS_D), (bf16_t*)(ws + WS_E), (bf16_t*)(ws + WS_F), (bf16_t*)(ws + WS_G), (bf16_t*)(ws + WS_QL), (bf16_t*)(ws + WS_KVL), (bf16_t*)(ws + WS_KPE),
            (float*)(ws + WS_STAT), (float*)(ws + WS_STAT) + 2 * M_, (float*)(ws + WS_STAT) + 3 * M_, (const float*)(ws + WS_COS), (const float*)(ws + WS_SIN)};
        run_gemm(lds, (const bf16_t*)a.out, (const bf16_t*)(ws + WS_WIN), 9216, 2048, 2048, 256, E, G, wv); }
    SEAM(2);
    if (IN(4)) {
        if (REP(13)) mix_phase(a, lds, G, wv, WS_KN);
        mix_phase(a, lds, G, wv);
        for (int rep_ = 0; rep_ <= REP(4); ++rep_) {
        { pg8::EpiQ E{(bf16_t*)a.out, QSCALE, (const float*)(ws + WS_STAT) + 2 * M_, 1.0f / 512.0f}; run_gemm(lds, (const bf16_t*)(ws + WS_QL), (const bf16_t*)(ws + WS_WUQ), 3072, 512, 512, 256, E, G, wv); }
        __syncthreads();
        { pg8::EpiKV E{(bf16_t*)(ws + WS_KN), (bf16_t*)(ws + WS_VT), (const float*)(ws + WS_STAT) + 3 * M_}; run_gemm(lds, (const bf16_t*)(ws + WS_KVL), (const bf16_t*)(ws + WS_WUKV), 4096, 256, 256, 256, E, G, wv); }
        __syncthreads(); }
    }
    SEAM(4);
    if (IN(5)) {
        for (int rep_ = 0; rep_ <= REP(5); ++rep_) attn_phase(a, lds, G, wv);
        __syncthreads();
        { pg8::EpiMulInPlace E{(bf16_t*)(ws + WS_F)}; run_gemm(lds, (const bf16_t*)(ws + WS_D), (const bf16_t*)(ws + WS_WA), 2048, 2048, 2048, 256, E, G, wv); }
    }
    SEAM(5);
    if (IN(6)) { pg8::EpiMerge E{(bf16_t*)(ws + WS_F), (const bf16_t*)(ws + WS_G)}; run_gemm(lds, (const bf16_t*)(ws + WS_E), (const bf16_t*)(ws + WS_WB), 2048, 2048, 2048, 256, E, G, wv); }
    SEAM(6);
    if (IN(7)) for (int rep_ = 0; rep_ <= REP(7); ++rep_) { __syncthreads(); pg8::EpiBf16 E{(bf16_t*)a.out, 4096, 1.0f, nullptr, 0.f};   run_gemm(lds, (const bf16_t*)(ws + WS_F), (const bf16_t*)(ws + WS_WOUT), 2048, 2048, 2048, 256, E, G, wv); }
    SEAM(7);
    if (IN(8)) { if (REP(8)) { phase8(a, lds, G, wv, WS_E); __syncthreads(); } phase8(a, lds, G, wv); }
    SEAM(8);
    if (IN(9)) for (int rep_ = 0; rep_ <= REP(9); ++rep_) { __syncthreads(); pg8::EpiUp E{(bf16_t*)(ws + WS_UP), (bf16_t*)(ws + WS_HALO)}; run_gemm(lds, (const bf16_t*)(ws + WS_D), (const bf16_t*)(ws + WS_WUP), 11264, 2048, 2048, 256, E, G, wv); }
    SEAM(9);
    if (IN(10)) { if (REP(10)) { phase10(a, G, wv, true); __syncthreads(); } phase10(a, G, wv); }
    SEAM(10);
    if (IN(11)) for (int rep_ = 0; rep_ <= REP(11); ++rep_) { __syncthreads(); pg8::EpiBf16 E{(bf16_t*)(ws + WS_D), 2048, 1.0f, nullptr, 0.f}; run_gemm(lds, (const bf16_t*)(ws + WS_UP), (const bf16_t*)(ws + WS_WDOWN), 2048, 5632, 5632, 256, E, G, wv); }
    SEAM(11);
    if (IN(12)) { if (REP(12)) { phase12(a, lds, G, wv, (float*)(ws + WS_UP)); __syncthreads(); } phase12(a, lds, G, wv); }
#undef IN
#undef SEAM
}

extern "C" void kernel_launch(void* const* d_in, const int* in_sizes, int n_in, void* d_out, int out_size, void* d_ws, size_t ws_size, hipStream_t stream) {
    static int grid = 0;
    if (grid == 0) {
        int dev = 0, cus = 0, per_cu = 0;
        hipGetDevice(&dev); hipDeviceGetAttribute(&cus, hipDeviceAttributeMultiprocessorCount, dev);
        if (hipFuncSetAttribute((const void*)fwd_kernel, hipFuncAttributeMaxDynamicSharedMemorySize, LDS_BYTES) != hipSuccess) fprintf(stderr, "kernel_launch: hipFuncSetAttribute failed\n");
        if (hipOccupancyMaxActiveBlocksPerMultiprocessor(&per_cu, (const void*)fwd_kernel, 512, LDS_BYTES) != hipSuccess || per_cu < 1) { fprintf(stderr, "kernel_launch: occupancy query says %d\n", per_cu); per_cu = 1; }
        (void)hipGetLastError();
        if (cus <= 0) cus = 256;
        grid = cus * per_cu;
        if (ws_size < 512 * MiB) fprintf(stderr, "kernel_launch: workspace too small: %zu\n", ws_size);
    }
    if (hipMemsetAsync(d_ws, 0, 16384, stream) != hipSuccess) fprintf(stderr, "kernel_launch: memset failed\n");
    Args a{};
    for (int i = 0; i < 25; ++i) a.in[i] = d_in[i];
    a.out = (float*)d_out; a.ws = (unsigned char*)d_ws;
    for (int i = 0; i < 32; ++i) a.inv[i] = (float)std::pow(10000.0, -(double)i / 32.0);
#if MK_LAUNCHES == 1
    a.ph_lo = 0; a.ph_hi = NPHASE;
    void* args[] = {&a};
    hipError_t e = hipLaunchCooperativeKernel((const void*)fwd_kernel, dim3(grid), dim3(512), args, LDS_BYTES, stream);
    if (e != hipSuccess) fprintf(stderr, "cooperative launch failed: %s (grid %d)\n", hipGetErrorString(e), grid);
#else
    for (int p = 0; p < NPHASE; ++p) { a.ph_lo = p; a.ph_hi = p + 1; hipLaunchKernelGGL(fwd_kernel, dim3(grid), dim3(512), LDS_BYTES, stream, a); }
#endif
}
```

```cpp
#include <hip/hip_runtime.h>
#include <hip/hip_cooperative_groups.h>
#include <cstdio>
#include <cstdint>
#include <cmath>
namespace cg = cooperative_groups;
#ifndef MK_LAUNCHES
#define MK_LAUNCHES 1
#endif
namespace pg8 {
#define PG8_LAS __attribute__((address_space(3)))
typedef unsigned short bf16_t;
typedef short bf16x8 __attribute__((ext_vector_type(8)));
typedef float f32x4 __attribute__((ext_vector_type(4)));
typedef unsigned u32x4 __attribute__((ext_vector_type(4)));
constexpr int BM = 256, BK = 64, HALF = 128, HTB = HALF * BK * 2  , STAGE_BYTES = 8 * HTB, NXCD = 8, WGM = 8;

__host__ __device__ __forceinline__ int lds_byte(int r, int c) { const int st = (r >> 4) * 2 + (c >> 5), rr = r & 15, cc = c & 31, ob = rr * 64 + cc * 2; return st * 1024 + (ob ^ (((ob >> 9) & 1) << 5)); }
__host__ __device__ __forceinline__ void stage_rc(int b, int& R, int& C) { const int st = b / 1024, sb = b % 1024, swz = sb ^ (((sb >> 9) & 1) << 5); R = (st >> 1) * 16 + swz / 64; C = (st & 1) * 32 + (swz % 64) / 2; }
__host__ __device__ __forceinline__ int perm32(int rho) { const int n = rho >> 4, i = rho & 15; return 8 * (i >> 2) + 4 * n + (i & 3); }

struct Unit { int pm, pn; };
struct Gemm { const bf16_t* A; const bf16_t* Bt; int M, N, K, lda, kpairA; };

struct StaticOrder {
    int nM, nN, nwg, G, c;
    __host__ __device__ void init(int M, int N, int G_, int c_) { nM = M / BM; nN = N / BM; nwg = nM * nN; G = G_; c = c_; }
    __host__ __device__ bool next(int i, Unit& u) const {
        const long L = (long)i * G + c; if (L >= nwg) return false;
        int wgid = (int)L; { const int q = nwg / NXCD, r = nwg % NXCD, xcd = wgid % NXCD, off = wgid / NXCD; wgid = (xcd < r ? xcd * (q + 1) : r * (q + 1) + (xcd - r) * q) + off; }
        const int nig = WGM * nN, gid = wgid / nig, fm = gid * WGM, gsz = (nM - fm) < WGM ? (nM - fm) : WGM;
        u.pm = fm + ((wgid % nig) % gsz); u.pn = (wgid % nig) / gsz; return true;
    }
    __device__ __forceinline__ void a_ready(const Unit&) const {}
    __device__ __forceinline__ void done(const Unit&) const {}
};


typedef unsigned u32x2 __attribute__((ext_vector_type(2)));
__device__ __forceinline__ unsigned cvt_pk_bf16(float lo, float hi) { unsigned r; asm("v_cvt_pk_bf16_f32 %0, %1, %2" : "=v"(r) : "v"(lo), "v"(hi)); return r; }
__device__ __forceinline__ float bf_lo(unsigned w) { return __uint_as_float(w << 16); }
__device__ __forceinline__ float bf_hi(unsigned w) { return __uint_as_float(w & 0xffff0000u); }
__device__ __forceinline__ float gelu_tanh(float v) { const float t = v * (1.0f + 0.044715f * v * v); const float e = __builtin_amdgcn_exp2f(-2.3022081986f * t); return v * __builtin_amdgcn_rcpf(1.0f + e); }
__device__ __forceinline__ float sigmoid_f(float v) { return __builtin_amdgcn_rcpf(1.0f + __builtin_amdgcn_exp2f(-1.4426950409f * v)); }
__device__ __forceinline__ u32x4 pack8(f32x4 a, f32x4 b) { u32x4 w; w.x = cvt_pk_bf16(a[0], a[1]); w.y = cvt_pk_bf16(a[2], a[3]); w.z = cvt_pk_bf16(b[0], b[1]); w.w = cvt_pk_bf16(b[2], b[3]); return w; }

struct EpiIn {
    static constexpr bool PERM = true, AFTER_DRAIN = false;
    bf16_t *GU, *GV, *SGA, *SGB, *QL, *KVL, *KPE; float *STV, *STQ, *STKV; const float *COS, *SIN;
    __device__ __forceinline__ void operator()(const f32x4 (&acc)[2][2][4][2], const Unit& u, int wr, int wc, int fr, int fq) const {
        const int pn = u.pn, row0 = u.pm * BM + wr * 64 + fr, cw = wc * 32 + 8 * fq;
        if (pn >= 16 && pn < 19) {
            bf16_t* base = pn < 18 ? QL : KVL; const int ld = pn < 18 ? 512 : 256, ct = pn == 17 ? 256 : 0; float* st = pn < 18 ? STQ : STKV;
#pragma unroll
            for (int ai = 0; ai < 2; ++ai)
#pragma unroll
                for (int m = 0; m < 4; ++m) { const int row = row0 + ai * HALF + m * 16; float ss = 0.f;
#pragma unroll
                    for (int bj = 0; bj < 2; ++bj) { const u32x4 w = pack8(acc[ai][bj][m][0], acc[ai][bj][m][1]); *(u32x4*)(base + (size_t)row * ld + ct + cw + bj * HALF) = w;
                        ss += (bf_lo(w.x) * bf_lo(w.x) + bf_hi(w.x) * bf_hi(w.x)) + (bf_lo(w.y) * bf_lo(w.y) + bf_hi(w.y) * bf_hi(w.y)) + (bf_lo(w.z) * bf_lo(w.z) + bf_hi(w.z) * bf_hi(w.z)) + (bf_lo(w.w) * bf_lo(w.w) + bf_hi(w.w) * bf_hi(w.w)); }
                    ss += __shfl_xor(ss, 16); ss += __shfl_xor(ss, 32);
                    if (fq == 0) unsafeAtomicAdd(st + row, ss); }
        } else if (pn == 19) {
            if (wc < 2) { const int i0 = 4 * (4 * wc + fq);
#pragma unroll
                for (int ai = 0; ai < 2; ++ai)
#pragma unroll
                    for (int m = 0; m < 4; ++m) { const int row = row0 + ai * HALF + m * 16;
                        const f32x4 c = *(const f32x4*)(COS + (size_t)row * 32 + i0), sn = *(const f32x4*)(SIN + (size_t)row * 32 + i0), x1 = acc[ai][0][m][0], x2 = acc[ai][0][m][1];
                        const f32x4 o1 = x1 * c - x2 * sn, o2 = x2 * c + x1 * sn;
                        u32x2 w1, w2; w1.x = cvt_pk_bf16(o1[0], o1[1]); w1.y = cvt_pk_bf16(o1[2], o1[3]); w2.x = cvt_pk_bf16(o2[0], o2[1]); w2.y = cvt_pk_bf16(o2[2], o2[3]);
                        *(u32x2*)(KPE + (size_t)row * 64 + i0) = w1; *(u32x2*)(KPE + (size_t)row * 64 + 32 + i0) = w2; } }
        } else {
            bf16_t* base; int ct; bool sg;
            if (pn < 8) { base = GU; ct = pn * 256; sg = false; } else if (pn < 16) { base = GV; ct = (pn - 8) * 256; sg = false; }
            else if (pn < 28) { base = SGA; ct = (pn - 20) * 256; sg = true; } else { base = SGB; ct = (pn - 28) * 256; sg = true; }
            const bool stat = pn >= 8 && pn < 16;
#pragma unroll
            for (int ai = 0; ai < 2; ++ai)
#pragma unroll
                for (int m = 0; m < 4; ++m) { const int row = row0 + ai * HALF + m * 16; bf16_t* rowp = base + (size_t)row * 2048 + ct + cw; float s1 = 0.f, s2 = 0.f;
#pragma unroll
                    for (int bj = 0; bj < 2; ++bj) { f32x4 v0 = acc[ai][bj][m][0], v1 = acc[ai][bj][m][1];
                        if (sg) {
#pragma unroll
                            for (int j = 0; j < 4; ++j) { v0[j] = sigmoid_f(v0[j]); v1[j] = sigmoid_f(v1[j]); }
                        } else {
#pragma unroll
                            for (int j = 0; j < 4; ++j) { v0[j] = gelu_tanh(v0[j]); v1[j] = gelu_tanh(v1[j]); }
                        }
                        const u32x4 w = pack8(v0, v1); *(u32x4*)(rowp + bj * HALF) = w;
                        if (stat) { const float a0 = bf_lo(w.x), a1 = bf_hi(w.x), a2 = bf_lo(w.y), a3 = bf_hi(w.y), a4 = bf_lo(w.z), a5 = bf_hi(w.z), a6 = bf_lo(w.w), a7 = bf_hi(w.w);
                            s1 += ((a0 + a1) + (a2 + a3)) + ((a4 + a5) + (a6 + a7)); s2 += ((a0 * a0 + a1 * a1) + (a2 * a2 + a3 * a3)) + ((a4 * a4 + a5 * a5) + (a6 * a6 + a7 * a7)); } }
                    if (stat) { s1 += __shfl_xor(s1, 16); s1 += __shfl_xor(s1, 32); s2 += __shfl_xor(s2, 16); s2 += __shfl_xor(s2, 32);
                        if (fq == 0) { unsafeAtomicAdd(STV + 2 * row, s1); unsafeAtomicAdd(STV + 2 * row + 1, s2); } } }
        }
    }
};
struct EpiBf16 {
    static constexpr bool PERM = true, AFTER_DRAIN = false;
    bf16_t* O; int ld; float sc; const float* rowss; float invn;
    __device__ __forceinline__ void operator()(const f32x4 (&acc)[2][2][4][2], const Unit& u, int wr, int wc, int fr, int fq) const {
        const int row0 = u.pm * BM + wr * 64 + fr, c0 = u.pn * BM + wc * 32 + 8 * fq;
#pragma unroll
        for (int ai = 0; ai < 2; ++ai)
#pragma unroll
            for (int m = 0; m < 4; ++m) { const int row = row0 + ai * HALF + m * 16; bf16_t* rowp = O + (size_t)row * ld + c0;
                const float scr = rowss ? sc * (1.0f / sqrtf(rowss[row] * invn + 1e-6f)) : sc;
#pragma unroll
                for (int bj = 0; bj < 2; ++bj) *(u32x4*)(rowp + bj * HALF) = pack8(acc[ai][bj][m][0] * scr, acc[ai][bj][m][1] * scr); }
    }
};
struct EpiKV {
    static constexpr bool PERM = true, AFTER_DRAIN = false;
    bf16_t *KN, *VT; const float* rowss;
    __device__ __forceinline__ void operator()(const f32x4 (&acc)[2][2][4][2], const Unit& u, int wr, int wc, int fr, int fq) const {
        const int h = u.pn, row0 = u.pm * BM + wr * 64 + fr, cw = wc * 32 + 8 * fq;
#pragma unroll
        for (int ai = 0; ai < 2; ++ai)
#pragma unroll
            for (int m = 0; m < 4; ++m) { const int row = row0 + ai * HALF + m * 16; const float scr = 1.0f / sqrtf(rowss[row] * (1.0f / 256.0f) + 1e-6f);
                *(u32x4*)(KN + (size_t)row * 2048 + h * 128 + cw) = pack8(acc[ai][0][m][0] * scr, acc[ai][0][m][1] * scr);
                *(u32x4*)(VT + (size_t)row * 2048 + h * 128 + cw) = pack8(acc[ai][1][m][0] * scr, acc[ai][1][m][1] * scr); }
    }
};
struct EpiMulInPlace {
    static constexpr bool PERM = true, AFTER_DRAIN = false;
    bf16_t* T;
    __device__ __forceinline__ void operator()(const f32x4 (&acc)[2][2][4][2], const Unit& u, int wr, int wc, int fr, int fq) const {
        const int row0 = u.pm * BM + wr * 64 + fr, c0 = u.pn * BM + wc * 32 + 8 * fq;
#pragma unroll
        for (int ai = 0; ai < 2; ++ai)
#pragma unroll
            for (int m = 0; m < 4; ++m) { bf16_t* rowp = T + (size_t)(row0 + ai * HALF + m * 16) * 2048 + c0;
#pragma unroll
                for (int bj = 0; bj < 2; ++bj) { const u32x4 g = *(const u32x4*)(rowp + bj * HALF); const f32x4 v0 = acc[ai][bj][m][0], v1 = acc[ai][bj][m][1];
                    const f32x4 o0 = {bf_lo(g.x) * v0[0], bf_hi(g.x) * v0[1], bf_lo(g.y) * v0[2], bf_hi(g.y) * v0[3]};
                    const f32x4 o1 = {bf_lo(g.z) * v1[0], bf_hi(g.z) * v1[1], bf_lo(g.w) * v1[2], bf_hi(g.w) * v1[3]};
                    *(u32x4*)(rowp + bj * HALF) = pack8(o0, o1); } }
    }
};
struct EpiMerge {
    static constexpr bool PERM = true, AFTER_DRAIN = false;
    bf16_t* T; const bf16_t* G;
    __device__ __forceinline__ void operator()(const f32x4 (&acc)[2][2][4][2], const Unit& u, int wr, int wc, int fr, int fq) const {
        const int row0 = u.pm * BM + wr * 64 + fr, c0 = u.pn * BM + wc * 32 + 8 * fq;
#pragma unroll
        for (int ai = 0; ai < 2; ++ai)
#pragma unroll
            for (int m = 0; m < 4; ++m) { const size_t off = (size_t)(row0 + ai * HALF + m * 16) * 2048 + c0;
#pragma unroll
                for (int bj = 0; bj < 2; ++bj) { const u32x4 t = *(const u32x4*)(T + off + bj * HALF); const u32x4 g = *(const u32x4*)(G + off + bj * HALF);
                    const f32x4 v0 = acc[ai][bj][m][0], v1 = acc[ai][bj][m][1];
                    const f32x4 o0 = {bf_lo(t.x) + bf_lo(g.x) * v0[0], bf_hi(t.x) + bf_hi(g.x) * v0[1], bf_lo(t.y) + bf_lo(g.y) * v0[2], bf_hi(t.y) + bf_hi(g.y) * v0[3]};
                    const f32x4 o1 = {bf_lo(t.z) + bf_lo(g.z) * v1[0], bf_hi(t.z) + bf_hi(g.z) * v1[1], bf_lo(t.w) + bf_lo(g.w) * v1[2], bf_hi(t.w) + bf_hi(g.w) * v1[3]};
                    *(u32x4*)(T + off + bj * HALF) = pack8(o0, o1); } }
    }
};
struct EpiUp {
    static constexpr bool PERM = true, AFTER_DRAIN = false;
    bf16_t *UP, *HALO;
    __device__ __forceinline__ void operator()(const f32x4 (&acc)[2][2][4][2], const Unit& u, int wr, int wc, int fr, int fq) const {
        const int row0 = u.pm * BM + wr * 64 + fr, c0 = u.pn * BM + wc * 32 + 8 * fq;
#pragma unroll
        for (int ai = 0; ai < 2; ++ai)
#pragma unroll
            for (int m = 0; m < 4; ++m) { const int row = row0 + ai * HALF + m * 16; bf16_t* rowp = UP + (size_t)row * 5632 + u.pn * HALF + wc * 32 + 8 * fq;
#pragma unroll
                for (int bj = 0; bj < 2; ++bj) { const u32x4 w = pack8(acc[ai][bj][m][0], acc[ai][bj][m][1]); __builtin_nontemporal_store(w, (u32x4*)(rowp + (size_t)bj * ((size_t)16384 * 5632)));
                    if (m == 3 && fr >= 14) *(u32x4*)(HALO + ((size_t)(row >> 6) * 2 + (fr - 14)) * 11264 + c0 + bj * HALF) = w; } }
    }
};
template <class Epi, class Sched, bool ALIGN_EPI = false, bool SP2 = false>
__device__ __forceinline__ void gemm_phase(PG8_LAS unsigned char* lds, const Gemm g, const Sched& S, const Epi& E, int wv) {
    int tid_; asm volatile("v_mbcnt_lo_u32_b32 %0, -1, 0\n\tv_mbcnt_hi_u32_b32 %0, -1, %0" : "=v"(tid_)); tid_ |= (wv << 6); const int tid = tid_, wid = __builtin_amdgcn_readfirstlane(tid >> 6), lane = tid & 63, wr = wid >> 2, wc = wid & 3, fr = lane & 15, fq = lane >> 4;
    const int K = g.K, nt = K / BK;
    unsigned voffA[2], voffB[2];
#pragma unroll
    for (int i = 0; i < 2; ++i) { int R, C; stage_rc(tid * 16 + i * 8192, R, C); const int Rb = Epi::PERM ? ((R & ~31) + perm32(R & 31)) : R;
        voffA[i] = (unsigned)(R * g.lda + C) * 2u; voffB[i] = (unsigned)(Rb * K + C) * 2u; }
    const size_t kstep = (size_t)(BK * 2);
    const size_t hstepA = (size_t)HALF * g.lda * 2, hstepB = (size_t)HALF * K * 2;
    const size_t tstepA = 2 * hstepA, tstepB = 2 * hstepB; const size_t kpairA = (size_t)g.kpairA;
    const unsigned ldsw = (unsigned)wid * 1024u;
    const int aoff = lds_byte(wr * 64 + fr, fq * 8), boff = lds_byte(wc * 32 + fr, fq * 8);
#define PG8_SA(b, h) (((b) * 2 + (h)) * HTB)
#define PG8_SB(b, h) ((4 + (b) * 2 + (h)) * HTB)
#define PG8_STAGE(bufoff, gbase, voff) do { _Pragma("unroll") for (int _i = 0; _i < 2; ++_i) \
        __builtin_amdgcn_global_load_lds((const unsigned*)((const char*)(gbase) + (voff)[_i]), (PG8_LAS unsigned*)(lds + (bufoff) + ldsw + _i * 8192), 16, 0, 0); } while (0)
#define PG8_LDA(dst, b, h) do { _Pragma("unroll") for (int m = 0; m < 4; ++m) _Pragma("unroll") for (int k = 0; k < 2; ++k) dst[m][k] = *(const PG8_LAS bf16x8*)(lds + PG8_SA(b, h) + aoff + m * 2048 + k * 1024); } while (0)
#define PG8_LDB(dst, b, h) do { _Pragma("unroll") for (int n = 0; n < 2; ++n) _Pragma("unroll") for (int k = 0; k < 2; ++k) dst[n][k] = *(const PG8_LAS bf16x8*)(lds + PG8_SB(b, h) + boff + n * 2048 + k * 1024); } while (0)
#define PG8_MMA(ai, bj, At, Bt) do { __builtin_amdgcn_s_setprio(1); _Pragma("unroll") for (int m = 0; m < 4; ++m) _Pragma("unroll") for (int n = 0; n < 2; ++n) _Pragma("unroll") for (int k = 0; k < 2; ++k) \
        acc[ai][bj][m][n] = __builtin_amdgcn_mfma_f32_16x16x32_bf16(Bt[n][k], At[m][k], acc[ai][bj][m][n], 0, 0, 0); __builtin_amdgcn_s_setprio(0); } while (0)
#define PG8_WAIT_V(n) asm volatile("s_waitcnt vmcnt(" #n ")" ::: "memory")
#define PG8_WAIT_L(n) asm volatile("s_waitcnt lgkmcnt(" #n ")" ::: "memory")
#define PG8_BAR __builtin_amdgcn_s_barrier()
#define PG8_SCHED __builtin_amdgcn_sched_barrier(0)
    Unit cur, nxt; int ui = 0;
    if (!S.next(0, cur)) return;
    f32x4 acc[2][2][4][2];
#pragma unroll
    for (int a = 0; a < 2; ++a)
#pragma unroll
        for (int b = 0; b < 2; ++b)
#pragma unroll
            for (int m = 0; m < 4; ++m)
#pragma unroll
                for (int n = 0; n < 2; ++n) acc[a][b][m][n] = (f32x4){0.f, 0.f, 0.f, 0.f};
    bf16x8 At[4][2], B0[2][2], B1[2][2];
    const char* cA = (const char*)g.A + (size_t)cur.pm * tstepA; const char* cB = (const char*)g.Bt + (size_t)cur.pn * tstepB;
    S.a_ready(cur);
    if constexpr (SP2) {
        PG8_STAGE(PG8_SB(0, 0), cB, voffB); PG8_STAGE(PG8_SB(0, 1), cB + hstepB, voffB); PG8_STAGE(PG8_SA(0, 0), cA, voffA); PG8_STAGE(PG8_SA(0, 1), cA + hstepA, voffA);
        if (wr == 1) PG8_BAR;
        PG8_WAIT_V(2); PG8_BAR;
        PG8_STAGE(PG8_SB(1, 0), cB + kstep, voffB); PG8_STAGE(PG8_SA(1, 0), cA + kstep, voffA); PG8_STAGE(PG8_SB(1, 1), cB + hstepB + kstep, voffB);
        PG8_WAIT_V(6); PG8_BAR;
    } else {
        PG8_STAGE(PG8_SB(0, 0), cB, voffB); PG8_STAGE(PG8_SA(0, 0), cA, voffA); PG8_STAGE(PG8_SB(0, 1), cB + hstepB, voffB); PG8_STAGE(PG8_SA(0, 1), cA + hstepA, voffA);
        if (wr == 1) PG8_BAR;
        PG8_WAIT_V(4); PG8_BAR;
        PG8_STAGE(PG8_SB(1, 0), cB + kstep, voffB); PG8_STAGE(PG8_SA(1, 0), cA + kstep, voffA); PG8_STAGE(PG8_SB(1, 1), cB + hstepB + kstep, voffB);
        PG8_WAIT_V(6); PG8_BAR;
    }
    for (;;) {
        const bool has_next = S.next(ui + 1, nxt);
        const char* nA = has_next ? (const char*)g.A + (size_t)nxt.pm * tstepA : cA; const char* nB = has_next ? (const char*)g.Bt + (size_t)nxt.pn * tstepB : cB;
        for (int t = 0; t < nt; t += 2) {
            const bool last = (t == nt - 2);
            const char* a1 = cA + (size_t)(t >> 1) * kpairA + kstep;
            const char* a2 = last ? nA : cA + (size_t)((t >> 1) + 1) * kpairA; const char* b2 = last ? nB : cB + (size_t)(t + 2) * kstep;
            const char* a3 = a2 + kstep; const char* b3 = b2 + kstep;
            if (last && has_next) S.a_ready(nxt);
            if constexpr (SP2) {
            PG8_LDB(B0, 0, 0); PG8_LDB(B1, 0, 1); PG8_SCHED; PG8_LDA(At, 0, 0); PG8_STAGE(PG8_SA(1, 1), a1 + hstepA, voffA);
            PG8_WAIT_V(8); PG8_WAIT_L(0); PG8_BAR; PG8_MMA(0, 0, At, B0); PG8_MMA(0, 1, At, B1); PG8_BAR; PG8_SCHED;
            PG8_LDA(At, 0, 1); PG8_STAGE(PG8_SB(0, 0), b2, voffB); PG8_STAGE(PG8_SB(0, 1), b2 + hstepB, voffB); PG8_STAGE(PG8_SA(0, 0), a2, voffA);
            PG8_WAIT_V(8); PG8_WAIT_L(0); PG8_BAR; PG8_MMA(1, 0, At, B0); PG8_MMA(1, 1, At, B1); PG8_BAR; PG8_SCHED;
            PG8_LDB(B0, 1, 0); PG8_LDB(B1, 1, 1); PG8_SCHED; PG8_LDA(At, 1, 0); PG8_STAGE(PG8_SA(0, 1), a2 + hstepA, voffA);
            PG8_WAIT_V(8); PG8_WAIT_L(0); PG8_BAR; PG8_MMA(0, 0, At, B0); PG8_MMA(0, 1, At, B1); PG8_BAR; PG8_SCHED;
            PG8_LDA(At, 1, 1); PG8_STAGE(PG8_SB(1, 0), b3, voffB); PG8_STAGE(PG8_SB(1, 1), b3 + hstepB, voffB); PG8_STAGE(PG8_SA(1, 0), a3, voffA);
            PG8_WAIT_V(8); PG8_WAIT_L(0); PG8_BAR; PG8_MMA(1, 0, At, B0); PG8_MMA(1, 1, At, B1); PG8_BAR; PG8_SCHED;
            } else {
            PG8_LDB(B0, 0, 0); PG8_SCHED; PG8_LDA(At, 0, 0); PG8_STAGE(PG8_SA(1, 1), a1 + hstepA, voffA);
            PG8_WAIT_L(8); PG8_BAR; PG8_WAIT_L(0); PG8_MMA(0, 0, At, B0); PG8_BAR; PG8_SCHED;
            PG8_LDB(B1, 0, 1); PG8_STAGE(PG8_SB(0, 0), b2, voffB);
            PG8_BAR; PG8_WAIT_L(0); PG8_MMA(0, 1, At, B1); PG8_BAR;
            PG8_LDA(At, 0, 1); PG8_STAGE(PG8_SA(0, 0), a2, voffA);
            PG8_BAR; PG8_WAIT_L(0); PG8_MMA(1, 0, At, B0); PG8_BAR; PG8_SCHED;
            PG8_STAGE(PG8_SB(0, 1), b2 + hstepB, voffB);
            PG8_WAIT_V(6); PG8_BAR; PG8_MMA(1, 1, At, B1); PG8_BAR;
            PG8_LDB(B0, 1, 0); PG8_SCHED; PG8_LDA(At, 1, 0); PG8_STAGE(PG8_SA(0, 1), a2 + hstepA, voffA);
            PG8_WAIT_L(8); PG8_BAR; PG8_WAIT_L(0); PG8_MMA(0, 0, At, B0); PG8_BAR; PG8_SCHED;
            PG8_LDB(B1, 1, 1); PG8_STAGE(PG8_SB(1, 0), b3, voffB);
            PG8_BAR; PG8_WAIT_L(0); PG8_MMA(0, 1, At, B1); PG8_BAR;
            PG8_LDA(At, 1, 1); PG8_STAGE(PG8_SA(1, 0), a3, voffA);
            PG8_BAR; PG8_WAIT_L(0); PG8_MMA(1, 0, At, B0); PG8_BAR; PG8_SCHED;
            PG8_STAGE(PG8_SB(1, 1), b3 + hstepB, voffB);
            PG8_WAIT_V(6); PG8_BAR; PG8_MMA(1, 1, At, B1); PG8_BAR;
            }
        }
        if constexpr (ALIGN_EPI) { if (wr == 0) PG8_BAR; }
        if constexpr (!Epi::AFTER_DRAIN) { E(acc, cur, wr, wc, fr, fq); S.done(cur); }
        if (!has_next) break;
#pragma unroll
        for (int a = 0; a < 2; ++a)
#pragma unroll
            for (int b = 0; b < 2; ++b)
#pragma unroll
                for (int m = 0; m < 4; ++m)
#pragma unroll
                    for (int n = 0; n < 2; ++n) acc[a][b][m][n] = (f32x4){0.f, 0.f, 0.f, 0.f};
        cur = nxt; cA = nA; cB = nB; ++ui;
        if constexpr (ALIGN_EPI) { if (wr == 1) PG8_BAR; }
    }
    PG8_WAIT_V(0);
    if constexpr (!ALIGN_EPI) { if (wr == 0) PG8_BAR; }
    PG8_BAR;
    if constexpr (Epi::AFTER_DRAIN) { E.fused(acc, cur, wr, wc, fr, fq, lds, wid, lane); S.done(cur); }
#undef PG8_SA
#undef PG8_SB
#undef PG8_STAGE
#undef PG8_LDA
#undef PG8_LDB
#undef PG8_MMA
#undef PG8_WAIT_V
#undef PG8_WAIT_L
#undef PG8_BAR
#undef PG8_SCHED
}
}

using pg8::bf16_t; using pg8::bf16x8; using pg8::f32x4; using pg8::u32x4; using pg8::u32x2; using pg8::cvt_pk_bf16; using pg8::bf_lo; using pg8::bf_hi; using pg8::pack8;
#define LAS __attribute__((address_space(3)))
typedef float f32x16 __attribute__((ext_vector_type(16)));
constexpr int M_ = 16384, D_ = 2048, S_ = 2048;
constexpr float EPS_ = 1e-6f;
constexpr size_t MiB = (size_t)1 << 20;
constexpr size_t WS_MODP = 1 * MiB, WS_COS = 4 * MiB, WS_SIN = 6 * MiB, WS_KPE = 8 * MiB;
constexpr size_t WS_WIN = 10 * MiB, WS_QN = 10 * MiB, WS_KVN = 26 * MiB, WS_WUP = 10 * MiB;
constexpr size_t WS_WA = 54 * MiB, WS_WB = 62 * MiB, WS_WOUT = 70 * MiB, WS_WUQ = 78 * MiB, WS_WUKV = 81 * MiB, WS_WDOWN = 54 * MiB;
constexpr size_t WS_D = 83 * MiB, WS_E = 147 * MiB, WS_F = 211 * MiB, WS_G = 275 * MiB, WS_KN = 339 * MiB, WS_VT = 403 * MiB;
constexpr size_t WS_UP = 147 * MiB, WS_HALO = 499 * MiB;
constexpr size_t WS_QL = 467 * MiB, WS_KVL = 483 * MiB, WS_STAT = 491 * MiB;
constexpr int LDS_BYTES = 147456;
constexpr float QSCALE = 0.07216878364870322f * 1.4426950408889634f;

struct Args { const void* in[25]; float* out; unsigned char* ws; float inv[32]; int ph_lo, ph_hi; };

__device__ __forceinline__ float wave_sum(float v) {
#pragma unroll
    for (int o = 1; o < 64; o <<= 1) v += __shfl_xor(v, o);
    return v;
}
#define LDS_WAIT() asm volatile("s_waitcnt lgkmcnt(0)" ::: "memory")

__device__ __forceinline__ void transpose_matrix(const float* W, int K, int N, bf16_t* WT, int mode, LAS float* scr, int lane, int gw, int NGW, int& rot, const float* gain = nullptr) {
    const int nblk = N / 64, nitems = (K / 64) * nblk;
    LAS unsigned* s32 = (LAS unsigned*)scr; LAS unsigned short* s16 = (LAS unsigned short*)scr;
    int start = gw - (rot % NGW); if (start < 0) start += NGW;
    const int r = lane >> 4, col4 = (lane & 15) * 4, c = lane & 7;
    for (int it = start; it < nitems; it += NGW) {
        const int kb = it / nblk, nb = it % nblk, k0 = 64 * kb, n0 = 64 * nb;
        int rd = n0;
        if (mode == 1) rd = n0 < 4928 ? n0 : n0 + 192;
        else if (mode == 2) { const int isv = n0 >= 5632 ? 1 : 0; const int cc = n0 - isv * 5632; rd = 256 * (cc >> 7) + 128 * isv + (cc & 127); }
        f32x4 v[16];
        const float* wp = W + (size_t)(k0 + r) * N + n0 + col4;
#pragma unroll
        for (int i = 0; i < 16; ++i) v[i] = __builtin_nontemporal_load((const f32x4*)(wp + (size_t)(4 * i) * N));
#pragma unroll
        for (int i = 0; i < 16; ++i) { const int row = 4 * i + r; if (gain) v[i] = v[i] * gain[k0 + row];
            s32[row * 33 + (col4 >> 1)] = cvt_pk_bf16(v[i][0], v[i][1]); s32[row * 33 + (col4 >> 1) + 1] = cvt_pk_bf16(v[i][2], v[i][3]); }
        const bool kpe_blk = (mode == 1 && n0 == 4864);
        LDS_WAIT();
#pragma unroll
        for (int j = 0; j < 8; ++j) { const int n = (lane >> 3) + 8 * j; const LAS unsigned short* p = s16 + (8 * c) * 66 + n;
            u32x4 o; o.x = (unsigned)p[0 * 66] | ((unsigned)p[1 * 66] << 16); o.y = (unsigned)p[2 * 66] | ((unsigned)p[3 * 66] << 16);
            o.z = (unsigned)p[4 * 66] | ((unsigned)p[5 * 66] << 16); o.w = (unsigned)p[6 * 66] | ((unsigned)p[7 * 66] << 16);
            const int rdn = kpe_blk ? rd + 8 * ((n & 31) >> 2) + (n & 3) + ((n >> 5) << 2) : rd + n;
            if (mode == 0 && K != 5632) __builtin_nontemporal_store(o, (u32x4*)(WT + (size_t)rdn * K + k0 + 8 * c)); else *(u32x4*)(WT + (size_t)rdn * K + k0 + 8 * c) = o; }
        LDS_WAIT();
    }
    rot += nitems;
}

__device__ __forceinline__ f32x4 modv(const float* MODP, const float* b_ada, int b, int j, int c) {
    f32x4 v = *(const f32x4*)(b_ada + j * 2048 + c);
#pragma unroll
    for (int kc = 0; kc < 8; ++kc) v += *(const f32x4*)(MODP + (size_t)(kc * 8 + b) * 12288 + j * 2048 + c);
    return v;
}

__device__ __forceinline__ void phase0(const Args& a, LAS unsigned char* lds, int G, int wv) {
    int tid_; asm volatile("v_mbcnt_lo_u32_b32 %0, -1, 0\n\tv_mbcnt_hi_u32_b32 %0, -1, %0" : "=v"(tid_)); tid_ |= (wv << 6); const int tid = tid_, lane = tid & 63, wave = __builtin_amdgcn_readfirstlane(tid >> 6);
    const int gw = blockIdx.x * 8 + wave, NGW = G * 8;
    LAS float* SC = (LAS float*)lds;
    LAS float* scr = (LAS float*)(lds + 65536 + wave * 8448);
    const float* cin = (const float*)a.in[1];
    for (int idx = tid; idx < 8 * 2048; idx += 512) { const int b = idx >> 11, k = idx & 2047; const float v = cin[idx]; SC[k * 8 + b] = v / (1.0f + __expf(-v)); }
    __syncthreads();
    {
        const float* w_ada = (const float*)a.in[3]; float* MODP = (float*)(a.ws + WS_MODP);
        for (int it = gw; it < 384 * 5; it += NGW) {
            if (it % 5) continue;
            const int item = it / 5, nch = item % 48, kch = item / 48, n0 = nch * 256 + lane * 4;
            f32x4 acc[8];
#pragma unroll
            for (int b = 0; b < 8; ++b) acc[b] = (f32x4){0.f, 0.f, 0.f, 0.f};
            const float* wp = w_ada + (size_t)(kch * 256) * 12288 + n0;
#pragma unroll 8
            for (int k = 0; k < 256; ++k) {
                const f32x4 w = __builtin_nontemporal_load((const f32x4*)(wp + (size_t)k * 12288));
                const f32x4 s0 = *(const LAS f32x4*)(SC + (kch * 256 + k) * 8), s1 = *(const LAS f32x4*)(SC + (kch * 256 + k) * 8 + 4);
                acc[0] += w * s0[0]; acc[1] += w * s0[1]; acc[2] += w * s0[2]; acc[3] += w * s0[3];
                acc[4] += w * s1[0]; acc[5] += w * s1[1]; acc[6] += w * s1[2]; acc[7] += w * s1[3];
            }
#pragma unroll
            for (int b = 0; b < 8; ++b) *(f32x4*)(MODP + (size_t)(kch * 8 + b) * 12288 + n0) = acc[b];
        }
    }
    {
        const int* pos = (const int*)a.in[2]; float* COS = (float*)(a.ws + WS_COS); float* SIN = (float*)(a.ws + WS_SIN);
        for (int idx = blockIdx.x * 512 + tid; idx < M_ * 32; idx += G * 512) {
            const int row = idx >> 5, i = idx & 31;
            const float ang = (float)pos[row] * a.inv[i];
            const double turns = (double)ang * 0.15915494309189535; const float fr = (float)(turns - __builtin_rint(turns));
            COS[idx] = __builtin_amdgcn_cosf(fr); SIN[idx] = __builtin_amdgcn_sinf(fr);
        }
    }
    int rot = 0, tgw = gw, TNGW = NGW; bool conv = true;
    if (NGW == 2048) { const int nmb = (gw + 4) / 5 < 384 ? (gw + 4) / 5 : 384; conv = !((gw % 5 == 0) && (gw / 5 < 384)); tgw = gw - nmb; TNGW = 2048 - 384; }
    if (conv) {
    transpose_matrix((const float*)a.in[6], 2048, 9024, (bf16_t*)(a.ws + WS_WIN), 1, scr, lane, tgw, TNGW, rot);
    transpose_matrix((const float*)a.in[11], 2048, 2048, (bf16_t*)(a.ws + WS_WA), 0, scr, lane, tgw, TNGW, rot);
    transpose_matrix((const float*)a.in[16], 2048, 2048, (bf16_t*)(a.ws + WS_WB), 0, scr, lane, tgw, TNGW, rot);
    transpose_matrix((const float*)a.in[17], 2048, 2048, (bf16_t*)(a.ws + WS_WOUT), 0, scr, lane, tgw, TNGW, rot);
    transpose_matrix((const float*)a.in[13], 512, 3072, (bf16_t*)(a.ws + WS_WUQ), 0, scr, lane, tgw, TNGW, rot, (const float*)a.in[12]);
    transpose_matrix((const float*)a.in[15], 256, 4096, (bf16_t*)(a.ws + WS_WUKV), 0, scr, lane, tgw, TNGW, rot, (const float*)a.in[14]);
    }
    { u32x4* z = (u32x4*)(a.ws + WS_STAT); const u32x4 zz = {0u, 0u, 0u, 0u};
      for (int idx = blockIdx.x * 512 + tid; idx < 4 * M_ * 4 / 16; idx += G * 512) z[idx] = zz; }
    { u32x4* z = (u32x4*)((bf16_t*)(a.ws + WS_WIN) + (size_t)4928 * 2048); const u32x4 zz = {0u, 0u, 0u, 0u};
      for (int idx = blockIdx.x * 512 + tid; idx < 192 * 2048 / 8; idx += G * 512) z[idx] = zz; }
}

__device__ __forceinline__ void phase1(const Args& a, LAS unsigned char* lds, int G, int wv) {
    int tid_; asm volatile("v_mbcnt_lo_u32_b32 %0, -1, 0\n\tv_mbcnt_hi_u32_b32 %0, -1, %0" : "=v"(tid_)); tid_ |= (wv << 6); const int tid = tid_, lane = tid & 63, wave = __builtin_amdgcn_readfirstlane(tid >> 6);
    const float* x = (const float*)a.in[0]; const float* b_ada = (const float*)a.in[4]; const float* g1 = (const float*)a.in[5];
    const float* MODP = (const float*)(a.ws + WS_MODP); bf16_t* H1 = (bf16_t*)a.out;
    LAS f32x4* A1 = (LAS f32x4*)lds; LAS f32x4* B1 = (LAS f32x4*)(lds + 8192);
    for (int r0 = blockIdx.x * 64; r0 < M_; r0 += G * 64) {
        const int b = r0 >> 11;
        __syncthreads();
        { const int c = tid * 4; const f32x4 sc = modv(MODP, b_ada, b, 1, c), sh = modv(MODP, b_ada, b, 0, c), g = *(const f32x4*)(g1 + c);
          A1[tid] = g * (sc + 1.0f); B1[tid] = sh; }
        __syncthreads();
        _Pragma("unroll 1") for (int rr = 0; rr < 8; ++rr) {
            const int row = r0 + wave * 8 + rr; const f32x4* xr = (const f32x4*)(x + (size_t)row * 2048);
            f32x4 v[8]; float ss = 0.f;
#pragma unroll
            for (int j = 0; j < 8; ++j) { v[j] = __builtin_nontemporal_load(&xr[lane + 64 * j]); ss += (v[j][0] * v[j][0] + v[j][1] * v[j][1]) + (v[j][2] * v[j][2] + v[j][3] * v[j][3]); }
            const float rstd = 1.0f / sqrtf(wave_sum(ss) * (1.0f / 2048.0f) + EPS_);
            u32x2* o = (u32x2*)(H1 + (size_t)row * 2048);
#pragma unroll
            for (int j = 0; j < 8; ++j) { const f32x4 h = v[j] * rstd * A1[lane + 64 * j] + B1[lane + 64 * j]; u32x2 w; w.x = cvt_pk_bf16(h[0], h[1]); w.y = cvt_pk_bf16(h[2], h[3]); o[lane + 64 * j] = w; }
        }
    }
}

__device__ __forceinline__ void mix_phase(const Args& a, LAS unsigned char* lds, int G, int wv, size_t aa_out = WS_D) {
    int tid_; asm volatile("v_mbcnt_lo_u32_b32 %0, -1, 0\n\tv_mbcnt_hi_u32_b32 %0, -1, %0" : "=v"(tid_)); tid_ |= (wv << 6); const int tid = tid_, lane = tid & 63, w = __builtin_amdgcn_readfirstlane(tid >> 6);
    const float* Ws = (const float*)a.in[9]; const float* bs = (const float*)a.in[10];
    const bf16_t* VN = (const bf16_t*)(a.ws + WS_E); bf16_t* GU = (bf16_t*)(a.ws + WS_D);
    const float* STV = (const float*)(a.ws + WS_STAT); const float* lng = (const float*)a.in[7]; const float* lnb = (const float*)a.in[8];
    LAS unsigned char* Wl = lds; LAS unsigned char* Vl = lds + 34816;
    int gl = -1;
    for (int it = blockIdx.x; it < 2048; it += G) {
        const int g = it & 15, bc = it >> 4, r0 = (bc >> 4) * 2048 + (bc & 15) * 128, c0 = g * 128;
        __syncthreads();
        if (g != gl) { gl = g;
#pragma unroll
            for (int i = 0; i < 8; ++i) { const int idx4 = tid + 512 * i, q = idx4 >> 5, p4 = (idx4 & 31) * 4; f32x4 wv = *(const f32x4*)(Ws + (size_t)g * 16384 + q * 128 + p4);
#pragma unroll
                for (int j = 0; j < 4; ++j) if (p4 + j > q) wv[j] = 0.f;
                u32x2 o; o.x = cvt_pk_bf16(wv[0], wv[1]); o.y = cvt_pk_bf16(wv[2], wv[3]); *(LAS u32x2*)(Wl + q * 272 + p4 * 2) = o; } }
#pragma unroll
        for (int i = 0; i < 4; ++i) { const int id = tid + 512 * i, p = id >> 4, dc = id & 15; const u32x4 vr = *(const u32x4*)(VN + (size_t)(r0 + p) * 2048 + c0 + dc * 8);
            const float mean = STV[2 * (r0 + p)] * (1.0f / 2048.0f), rstd = 1.0f / sqrtf(fmaxf(STV[2 * (r0 + p) + 1] * (1.0f / 2048.0f) - mean * mean, 0.f) + EPS_);
            const f32x4 g0 = *(const f32x4*)(lng + c0 + dc * 8), g1 = *(const f32x4*)(lng + c0 + dc * 8 + 4), b0 = *(const f32x4*)(lnb + c0 + dc * 8), b1 = *(const f32x4*)(lnb + c0 + dc * 8 + 4);
            const f32x4 x0 = {bf_lo(vr.x), bf_hi(vr.x), bf_lo(vr.y), bf_hi(vr.y)}, x1 = {bf_lo(vr.z), bf_hi(vr.z), bf_lo(vr.w), bf_hi(vr.w)};
            const u32x4 v = pack8((x0 - mean) * rstd * g0 + b0, (x1 - mean) * rstd * g1 + b1);
            LAS unsigned short* vd = (LAS unsigned short*)(Vl + (dc * 8) * 272 + p * 2);
            vd[0 * 136] = (unsigned short)(v.x & 0xffffu); vd[1 * 136] = (unsigned short)(v.x >> 16); vd[2 * 136] = (unsigned short)(v.y & 0xffffu); vd[3 * 136] = (unsigned short)(v.y >> 16);
            vd[4 * 136] = (unsigned short)(v.z & 0xffffu); vd[5 * 136] = (unsigned short)(v.z >> 16); vd[6 * 136] = (unsigned short)(v.w & 0xffffu); vd[7 * 136] = (unsigned short)(v.w >> 16); }
        __syncthreads();
        u32x4 gur[4];
#pragma unroll
        for (int i = 0; i < 4; ++i) gur[i] = *(const u32x4*)(GU + (size_t)(r0 + 16 * w + 4 * i + (lane >> 4)) * 2048 + c0 + (lane & 15) * 8);
        f32x4 acc[8];
#pragma unroll
        for (int mb = 0; mb < 8; ++mb) acc[mb] = (f32x4){0.f, 0.f, 0.f, 0.f};
        const int nks = (w >> 1) + 1;
        for (int ks = 0; ks < nks; ++ks) {
            const bf16x8 bw = *(const LAS bf16x8*)(Wl + (16 * w + (lane & 15)) * 272 + ks * 64 + (lane >> 4) * 16);
#pragma unroll
            for (int mb = 0; mb < 8; ++mb) { const bf16x8 av = *(const LAS bf16x8*)(Vl + (16 * mb + (lane & 15)) * 272 + ks * 64 + (lane >> 4) * 16);
                acc[mb] = __builtin_amdgcn_mfma_f32_16x16x32_bf16(av, bw, acc[mb], 0, 0, 0); }
        }
        { const int q = lane & 15, quad = lane >> 4; const float bias = bs[g * 128 + 16 * w + q];
          LAS unsigned char* stg = lds + 69632 + w * 8448;
#pragma unroll
          for (int mb = 0; mb < 8; ++mb) *(LAS f32x4*)(stg + q * 528 + (16 * mb + 4 * quad) * 4) = acc[mb] + bias;
          asm volatile("s_waitcnt lgkmcnt(0)" ::: "memory");
#pragma unroll
          for (int i = 0; i < 4; ++i) { const int rl = 4 * i + (lane >> 4), ch = lane & 15;
              const f32x4 m0 = *(const LAS f32x4*)(stg + rl * 528 + ch * 32), m1 = *(const LAS f32x4*)(stg + rl * 528 + ch * 32 + 16); const u32x4 uu = gur[i];
              const f32x4 o0 = {bf_lo(uu.x) * m0[0], bf_hi(uu.x) * m0[1], bf_lo(uu.y) * m0[2], bf_hi(uu.y) * m0[3]}, o1 = {bf_lo(uu.z) * m1[0], bf_hi(uu.z) * m1[1], bf_lo(uu.w) * m1[2], bf_hi(uu.w) * m1[3]};
              *(u32x4*)((bf16_t*)(a.ws + aa_out) + (size_t)(r0 + 16 * w + rl) * 2048 + c0 + ch * 8) = pack8(o0, o1); }
          asm volatile("s_waitcnt lgkmcnt(0)" ::: "memory"); }
    }
    __syncthreads();
}

__device__ __forceinline__ void att_glds16(const void* gsrc, unsigned lds_dst) { unsigned keep;
    asm volatile("s_mov_b32 %0, m0\n\ts_mov_b32 m0, %2\n\ts_nop 0\n\tglobal_load_lds_dwordx4 %1, off\n\ts_mov_b32 m0, %0" : "=&s"(keep) : "v"(gsrc), "s"(lds_dst) : "memory"); }
constexpr int AK_PITCH = 400, AV_PITCH = 320, AK_BYTES = 64 * AK_PITCH, AV_BYTES = 64 * AV_PITCH;
typedef short att_v4i16 __attribute__((ext_vector_type(4)));
__device__ __forceinline__ void attn_unit(int bh, int qb, const bf16_t* Q, const bf16_t* KN, const bf16_t* KPE, const bf16_t* VT, const float* COS, const float* SIN, bf16_t* O, LAS unsigned char* lds, int wv) {
    int tid_; asm volatile("v_mbcnt_lo_u32_b32 %0, -1, 0\n\tv_mbcnt_hi_u32_b32 %0, -1, %0" : "=v"(tid_)); tid_ |= (wv << 6); const int tid = tid_, lane = tid & 63, wid = __builtin_amdgcn_readfirstlane(tid >> 6), r32 = lane & 31, hi = lane >> 5;
    const int b = bh >> 4, h = bh & 15, q0 = qb * 256;
    const size_t rowbase = (size_t)b * 2048;
    const int qrow = q0 + 32 * wid + r32;
    const unsigned lds0 = (unsigned)(uintptr_t)lds;
    const bf16_t* csrc[6]; int cstep[6]; unsigned cdst[6];
#pragma unroll
    for (int i = 0; i < 6; ++i) { int id = wid + 8 * i; if (id > 44) id = 44;
        if (id < 25) { const int c = id * 1024 + 16 * lane, row = c / AK_PITCH, col = c % AK_PITCH;
            if (col < 256) { csrc[i] = KN + (rowbase + row) * 2048 + h * 128 + (col >> 1); cstep[i] = 64 * 2048; }
            else if (col < 384) { csrc[i] = KPE + (rowbase + row) * 64 + ((col - 256) >> 1); cstep[i] = 64 * 64; }
            else { csrc[i] = KN + (rowbase + row) * 2048 + h * 128; cstep[i] = 64 * 2048; }
            cdst[i] = (unsigned)(id * 1024); }
        else { const int c = (id - 25) * 1024 + 16 * lane, row = c / AV_PITCH, col = c % AV_PITCH;
            csrc[i] = VT + (rowbase + row) * 2048 + h * 128 + (col < 256 ? (col >> 1) : 0); cstep[i] = 64 * 2048;
            cdst[i] = (unsigned)(3 * AK_BYTES + (id - 25) * 1024); } }
    const int NT = (q0 + 256) / 64;
#define ATT_ISSUE(tt, slot) do { _Pragma("unroll") for (int i_ = 0; i_ < 6; ++i_) { \
        const unsigned dst_ = lds0 + cdst[i_] + (unsigned)(slot) * (unsigned)((wid + 8 * i_ < 25) ? AK_BYTES : AV_BYTES); \
        att_glds16(csrc[i_] + (size_t)(tt) * cstep[i_], (unsigned)__builtin_amdgcn_readfirstlane(dst_)); } } while (0)
    ATT_ISSUE(0, 0); ATT_ISSUE(1, 1);
    bf16x8 qf[12];
    { const bf16_t* qp = Q + (rowbase + qrow) * 3072 + h * 192 + 8 * hi;
#pragma unroll
      for (int d0 = 0; d0 < 12; ++d0) qf[d0] = *(const bf16x8*)(qp + 16 * d0);
#pragma unroll
      for (int e = 0; e < 2; ++e) { const int i0 = 16 * e + 8 * hi; const float* cp = COS + (rowbase + qrow) * 32 + i0; const float* sp = SIN + (rowbase + qrow) * 32 + i0;
          const f32x4 c0 = *(const f32x4*)cp, c1 = *(const f32x4*)(cp + 4), s0 = *(const f32x4*)sp, s1 = *(const f32x4*)(sp + 4);
          const u32x4 x1 = __builtin_bit_cast(u32x4, qf[8 + e]), x2 = __builtin_bit_cast(u32x4, qf[10 + e]); u32x4 n1, n2;
#define ROPE2(W1, W2, O1, O2, CA, SA, CB, SB) { const float a1 = bf_lo(W1), a2 = bf_lo(W2), b1 = bf_hi(W1), b2 = bf_hi(W2); \
              O1 = cvt_pk_bf16(a1 * (CA) - a2 * (SA), b1 * (CB) - b2 * (SB)); O2 = cvt_pk_bf16(a2 * (CA) + a1 * (SA), b2 * (CB) + b1 * (SB)); }
          ROPE2(x1.x, x2.x, n1.x, n2.x, c0[0], s0[0], c0[1], s0[1]); ROPE2(x1.y, x2.y, n1.y, n2.y, c0[2], s0[2], c0[3], s0[3]);
          ROPE2(x1.z, x2.z, n1.z, n2.z, c1[0], s1[0], c1[1], s1[1]); ROPE2(x1.w, x2.w, n1.w, n2.w, c1[2], s1[2], c1[3], s1[3]);
#undef ROPE2
          qf[8 + e] = __builtin_bit_cast(bf16x8, n1); qf[10 + e] = __builtin_bit_cast(bf16x8, n2); } }
    asm volatile("s_waitcnt vmcnt(0)\n\ts_barrier" ::: "memory");
    f32x16 o[4];
#pragma unroll
    for (int d0 = 0; d0 < 4; ++d0)
#pragma unroll
        for (int r = 0; r < 16; ++r) o[d0][r] = 0.f;
    float m_run = -1e30f, l_run = 0.f;
    int s0i = 0, s1i = 1, s2 = 2;
    for (int t = 0; t < NT; ++t) {
        const bool more2 = t + 2 < NT;
        if (more2) ATT_ISSUE(t + 2, s2);
        const int buf = s0i;
        if (64 * t <= q0 + 32 * wid + 31) {
            const LAS unsigned char* kb = lds + buf * AK_BYTES + r32 * AK_PITCH + hi * 16;
            f32x16 s0, s1;
#pragma unroll
            for (int r = 0; r < 16; ++r) { s0[r] = 0.f; s1[r] = 0.f; }
#pragma unroll
            for (int d0 = 0; d0 < 12; ++d0) { const bf16x8 k0 = *(const LAS bf16x8*)(kb + d0 * 32), k1 = *(const LAS bf16x8*)(kb + 32 * AK_PITCH + d0 * 32);
                s0 = __builtin_amdgcn_mfma_f32_32x32x16_bf16(k0, qf[d0], s0, 0, 0, 0); s1 = __builtin_amdgcn_mfma_f32_32x32x16_bf16(k1, qf[d0], s1, 0, 0, 0); }
            if (t >= NT - 4) {
                const int kv0 = 64 * t + 4 * hi;
#pragma unroll
                for (int r = 0; r < 16; ++r) { const int kv = kv0 + (r & 3) + 8 * (r >> 2); if (kv > qrow) s0[r] = -1e30f; if (kv + 32 > qrow) s1[r] = -1e30f; }
            }
            float mx = s0[0];
#pragma unroll
            for (int r = 1; r < 16; ++r) mx = fmaxf(mx, s0[r]);
#pragma unroll
            for (int r = 0; r < 16; ++r) mx = fmaxf(mx, s1[r]);
            mx = fmaxf(mx, __shfl_xor(mx, 32));
            const bool grow = mx > m_run + 6.0f;
            if (__builtin_amdgcn_ballot_w64(grow) != 0ull) {
                const float m_new = grow ? mx : m_run, alpha = __builtin_amdgcn_exp2f(m_run - m_new); m_run = m_new; l_run *= alpha;
#pragma unroll
                for (int d0 = 0; d0 < 4; ++d0)
#pragma unroll
                    for (int r = 0; r < 16; ++r) o[d0][r] *= alpha;
            }
            float ls = 0.f;
#pragma unroll
            for (int r = 0; r < 16; ++r) { s0[r] = __builtin_amdgcn_exp2f(s0[r] - m_run); s1[r] = __builtin_amdgcn_exp2f(s1[r] - m_run); ls += s0[r] + s1[r]; }
            l_run += ls;
            bf16x8 pf[4];
            { u32x4 w;
              w.x = cvt_pk_bf16(s0[0], s0[1]); w.y = cvt_pk_bf16(s0[2], s0[3]); w.z = cvt_pk_bf16(s0[4], s0[5]); w.w = cvt_pk_bf16(s0[6], s0[7]); pf[0] = __builtin_bit_cast(bf16x8, w);
              w.x = cvt_pk_bf16(s0[8], s0[9]); w.y = cvt_pk_bf16(s0[10], s0[11]); w.z = cvt_pk_bf16(s0[12], s0[13]); w.w = cvt_pk_bf16(s0[14], s0[15]); pf[1] = __builtin_bit_cast(bf16x8, w);
              w.x = cvt_pk_bf16(s1[0], s1[1]); w.y = cvt_pk_bf16(s1[2], s1[3]); w.z = cvt_pk_bf16(s1[4], s1[5]); w.w = cvt_pk_bf16(s1[6], s1[7]); pf[2] = __builtin_bit_cast(bf16x8, w);
              w.x = cvt_pk_bf16(s1[8], s1[9]); w.y = cvt_pk_bf16(s1[10], s1[11]); w.z = cvt_pk_bf16(s1[12], s1[13]); w.w = cvt_pk_bf16(s1[14], s1[15]); pf[3] = __builtin_bit_cast(bf16x8, w); }
            const LAS unsigned char* vb = lds + 3 * AK_BYTES + buf * AV_BYTES + (4 * hi + ((lane & 15) >> 2)) * AV_PITCH + (16 * ((lane >> 4) & 1) + 4 * (lane & 3)) * 2;
#pragma unroll
            for (int d0 = 0; d0 < 4; ++d0)
#pragma unroll
                for (int ks = 0; ks < 4; ++ks) {
                    const att_v4i16 lo4 = __builtin_amdgcn_ds_read_tr16_b64_v4i16((LAS att_v4i16*)(vb + ks * 16 * AV_PITCH + d0 * 64));
                    const att_v4i16 hi4 = __builtin_amdgcn_ds_read_tr16_b64_v4i16((LAS att_v4i16*)(vb + (ks * 16 + 8) * AV_PITCH + d0 * 64));
                    const bf16x8 vf = {lo4[0], lo4[1], lo4[2], lo4[3], hi4[0], hi4[1], hi4[2], hi4[3]};
                    o[d0] = __builtin_amdgcn_mfma_f32_32x32x16_bf16(vf, pf[ks], o[d0], 0, 0, 0); }
        }
        { const int tmp_ = s0i; s0i = s1i; s1i = s2; s2 = tmp_; }
        if (more2) asm volatile("s_waitcnt vmcnt(6) lgkmcnt(0)\n\ts_barrier" ::: "memory");
        else asm volatile("s_waitcnt vmcnt(0) lgkmcnt(0)\n\ts_barrier" ::: "memory");
    }
#undef ATT_ISSUE
    const float l = l_run + __shfl_xor(l_run, 32), il = 1.0f / l;
    { LAS unsigned char* stg = lds + wid * 8704;
#pragma unroll
      for (int d0 = 0; d0 < 4; ++d0)
#pragma unroll
          for (int rq = 0; rq < 4; ++rq) { u32x2 w; w.x = cvt_pk_bf16(o[d0][4 * rq] * il, o[d0][4 * rq + 1] * il); w.y = cvt_pk_bf16(o[d0][4 * rq + 2] * il, o[d0][4 * rq + 3] * il);
              *(LAS u32x2*)(stg + r32 * 272 + (32 * d0 + 8 * rq + 4 * hi) * 2) = w; }
      asm volatile("s_waitcnt lgkmcnt(0)" ::: "memory");
      bf16_t* ob = O + (rowbase + q0 + 32 * wid) * 2048 + h * 128;
#pragma unroll
      for (int i = 0; i < 8; ++i) { const int row = 4 * i + (lane >> 4), ch = lane & 15; const u32x4 v = *(const LAS u32x4*)(stg + row * 272 + ch * 16); *(u32x4*)(ob + (size_t)row * 2048 + ch * 8) = v; }
      asm volatile("s_waitcnt lgkmcnt(0)\n\ts_barrier" ::: "memory"); }
}
__device__ __forceinline__ void attn_phase(const Args& a, LAS unsigned char* lds, int G, int wv) {
    const bf16_t* Q = (const bf16_t*)a.out; const bf16_t* KN = (const bf16_t*)(a.ws + WS_KN); const bf16_t* KPE = (const bf16_t*)(a.ws + WS_KPE); const bf16_t* VT = (const bf16_t*)(a.ws + WS_VT);
    const float* COS = (const float*)(a.ws + WS_COS); const float* SIN = (const float*)(a.ws + WS_SIN); bf16_t* O = (bf16_t*)(a.ws + WS_E);
    for (int L = blockIdx.x; L < 1024; L += G) {
        const int i = L >> 8, c = L & 255, bh = c >> 1, s = c & 1;
        const int qb = (i == 0) ? (s ? 6 : 7) : (i == 1) ? (s ? 1 : 0) : (i == 2) ? (s ? 4 : 5) : (s ? 3 : 2);
        attn_unit(bh, qb, Q, KN, KPE, VT, COS, SIN, O, lds, wv);
    }
    __syncthreads();
}

__device__ __forceinline__ void phase8(const Args& a, LAS unsigned char* lds, int G, int wv, size_t h2_out = WS_D) {
    int tid_; asm volatile("v_mbcnt_lo_u32_b32 %0, -1, 0\n\tv_mbcnt_hi_u32_b32 %0, -1, %0" : "=v"(tid_)); tid_ |= (wv << 6); const int tid = tid_, lane = tid & 63, wave = __builtin_amdgcn_readfirstlane(tid >> 6);
    const float* x = (const float*)a.in[0]; const float* b_ada = (const float*)a.in[4]; const float* gp1 = (const float*)a.in[18]; const float* g2 = (const float*)a.in[19];
    const float* MODP = (const float*)(a.ws + WS_MODP); const bf16_t* Y = (const bf16_t*)a.out;
    LAS float* G1 = (LAS float*)lds; LAS float* A2 = (LAS float*)(lds + 8192); LAS float* B2 = (LAS float*)(lds + 16384);
    for (int r0 = blockIdx.x * 64; r0 < M_; r0 += G * 64) {
        const int b = r0 >> 11;
        __syncthreads();
        { const int c = tid * 4; *(LAS f32x4*)(G1 + c) = modv(MODP, b_ada, b, 2, c) * *(const f32x4*)(gp1 + c);
          *(LAS f32x4*)(A2 + c) = *(const f32x4*)(g2 + c) * (modv(MODP, b_ada, b, 4, c) + 1.0f); *(LAS f32x4*)(B2 + c) = modv(MODP, b_ada, b, 3, c); }
        __syncthreads();
        _Pragma("unroll 1") for (int rr = 0; rr < 8; ++rr) {
            const int row = r0 + wave * 8 + rr; const u32x4* yp = (const u32x4*)(Y + (size_t)row * 4096); const float* xr = x + (size_t)row * 2048;
            float f[4][8]; float ss = 0.f;
#pragma unroll
            for (int j = 0; j < 4; ++j) { const u32x4 w = yp[lane + 64 * j];
                f[j][0] = bf_lo(w.x); f[j][1] = bf_hi(w.x); f[j][2] = bf_lo(w.y); f[j][3] = bf_hi(w.y); f[j][4] = bf_lo(w.z); f[j][5] = bf_hi(w.z); f[j][6] = bf_lo(w.w); f[j][7] = bf_hi(w.w);
#pragma unroll
                for (int e = 0; e < 8; ++e) ss += f[j][e] * f[j][e]; }
            const float ry = 1.0f / sqrtf(wave_sum(ss) * (1.0f / 2048.0f) + EPS_);
            float s2 = 0.f;
#pragma unroll
            for (int j = 0; j < 4; ++j) { const int c = 8 * (lane + 64 * j);
                const f32x4 xa = __builtin_nontemporal_load((const f32x4*)(xr + c)), xb = __builtin_nontemporal_load((const f32x4*)(xr + c + 4)), ga = *(const LAS f32x4*)(G1 + c), gb = *(const LAS f32x4*)(G1 + c + 4);
                f32x4 ya = {f[j][0], f[j][1], f[j][2], f[j][3]}, yb = {f[j][4], f[j][5], f[j][6], f[j][7]};
                ya = xa + ga * ya * ry; yb = xb + gb * yb * ry;
#pragma unroll
                for (int e = 0; e < 4; ++e) { f[j][e] = ya[e]; f[j][4 + e] = yb[e]; s2 += ya[e] * ya[e] + yb[e] * yb[e]; } }
            const float rx = 1.0f / sqrtf(wave_sum(s2) * (1.0f / 2048.0f) + EPS_);
#pragma unroll
            for (int j = 0; j < 4; ++j) { const int c = 8 * (lane + 64 * j);
                const f32x4 aa = *(const LAS f32x4*)(A2 + c), ab = *(const LAS f32x4*)(A2 + c + 4), ba = *(const LAS f32x4*)(B2 + c), bb = *(const LAS f32x4*)(B2 + c + 4);
                const f32x4 ha = {f[j][0] * rx * aa[0] + ba[0], f[j][1] * rx * aa[1] + ba[1], f[j][2] * rx * aa[2] + ba[2], f[j][3] * rx * aa[3] + ba[3]};
                const f32x4 hb = {f[j][4] * rx * ab[0] + bb[0], f[j][5] * rx * ab[1] + bb[1], f[j][6] * rx * ab[2] + bb[2], f[j][7] * rx * ab[3] + bb[3]};
                ((u32x4*)((bf16_t*)(a.ws + h2_out) + (size_t)row * 2048))[lane + 64 * j] = pack8(ha, hb); }
        }
    }
    __syncthreads();
    LAS float* scr = (LAS float*)(lds + 32768 + wave * 8448);
    const int gw = blockIdx.x * 8 + wave, NGW = G * 8; int rot = 0;
    transpose_matrix((const float*)a.in[20], 2048, 11264, (bf16_t*)(a.ws + WS_WUP), 2, scr, lane, gw, NGW, rot);
    transpose_matrix((const float*)a.in[23], 5632, 2048, (bf16_t*)(a.ws + WS_WDOWN), 0, scr, lane, gw, NGW, rot);
}

__device__ __forceinline__ f32x4 bf4(u32x2 w) { return (f32x4){bf_lo(w.x), bf_hi(w.x), bf_lo(w.y), bf_hi(w.y)}; }
__device__ __forceinline__ void phase10(const Args& a, int G, int wv, bool dummy = false) {
    int tid_; asm volatile("v_mbcnt_lo_u32_b32 %0, -1, 0\n\tv_mbcnt_hi_u32_b32 %0, -1, %0" : "=v"(tid_)); tid_ |= (wv << 6); const int tid = tid_, lane = tid & 63, wave = __builtin_amdgcn_readfirstlane(tid >> 6);
    const int gw = blockIdx.x * 8 + wave, NGW = G * 8;
    const float* cw = (const float*)a.in[21]; const float* cb = (const float*)a.in[22];
    bf16_t* UP = (bf16_t*)(a.ws + WS_UP); const bf16_t* HALO = (const bf16_t*)(a.ws + WS_HALO);
    for (int it = gw; it < 256 * 22; it += NGW) {
        const int rs = it / 22, cs = it % 22, row0 = rs * 64, pn = 2 * cs + (lane >> 5), j = (lane & 31) * 4, col = 256 * pn + j, ch = 128 * pn + j; constexpr size_t VPL = (size_t)16384 * 5632;
        const f32x4 wg0 = *(const f32x4*)(cw + ch), wg1 = *(const f32x4*)(cw + 11264 + ch), wg2 = *(const f32x4*)(cw + 22528 + ch), bg = *(const f32x4*)(cb + ch);
        const f32x4 wv0 = *(const f32x4*)(cw + 5632 + ch), wv1 = *(const f32x4*)(cw + 11264 + 5632 + ch), wv2 = *(const f32x4*)(cw + 22528 + 5632 + ch), bv = *(const f32x4*)(cb + 5632 + ch);
        f32x4 gm2 = {0.f, 0.f, 0.f, 0.f}, gm1 = gm2, vm2 = gm2, vm1 = gm2;
        if (row0 & 2047) { const bf16_t* hp = HALO + (size_t)(rs - 1) * 2 * 11264 + col;
            gm2 = bf4(*(const u32x2*)hp); gm1 = bf4(*(const u32x2*)(hp + 11264)); vm2 = bf4(*(const u32x2*)(hp + 128)); vm1 = bf4(*(const u32x2*)(hp + 11264 + 128)); }
        bf16_t* up = UP + (size_t)row0 * 5632 + ch;
        for (int t0 = 0; t0 < 64; t0 += 8) {
            u32x2 gr[8], vr[8];
#pragma unroll
            for (int t = 0; t < 8; ++t) { gr[t] = __builtin_nontemporal_load((const u32x2*)(up + (size_t)(t0 + t) * 5632)); vr[t] = __builtin_nontemporal_load((const u32x2*)(up + VPL + (size_t)(t0 + t) * 5632)); }
#pragma unroll
            for (int t = 0; t < 8; ++t) { const f32x4 gc = bf4(gr[t]), vc = bf4(vr[t]);
                const f32x4 gg = wg0 * gm2 + wg1 * gm1 + wg2 * gc + bg, vv = wv0 * vm2 + wv1 * vm1 + wv2 * vc + bv;
                f32x4 o;
#pragma unroll
                for (int e = 0; e < 4; ++e) o[e] = gg[e] * pg8::sigmoid_f(gg[e]) * vv[e];
                u32x2 w; w.x = cvt_pk_bf16(o[0], o[1]); w.y = cvt_pk_bf16(o[2], o[3]);
                if (dummy) *(u32x2*)((bf16_t*)(a.ws + WS_D) + ((((size_t)(row0 + t0 + t)) * 5632 + ch) & (size_t)0x1ffffff)) = w; else *(u32x2*)(up + (size_t)(t0 + t) * 5632) = w;
                gm2 = gm1; gm1 = gc; vm2 = vm1; vm1 = vc; }
        }
    }
}

__device__ __forceinline__ void phase12(const Args& a, LAS unsigned char* lds, int G, int wv, float* xout_base = nullptr) {
    int tid_; asm volatile("v_mbcnt_lo_u32_b32 %0, -1, 0\n\tv_mbcnt_hi_u32_b32 %0, -1, %0" : "=v"(tid_)); tid_ |= (wv << 6); const int tid = tid_, lane = tid & 63, wave = __builtin_amdgcn_readfirstlane(tid >> 6);
    (void)xout_base;
    const float* x = (const float*)a.in[0]; const float* b_ada = (const float*)a.in[4]; const float* gp1 = (const float*)a.in[18]; const float* gp2 = (const float*)a.in[24];
    const float* MODP = (const float*)(a.ws + WS_MODP); const bf16_t* F = (const bf16_t*)(a.ws + WS_D); const bf16_t* Y = (const bf16_t*)a.out; float* OUT = a.out;
    LAS float* G1 = (LAS float*)lds; LAS float* G2 = (LAS float*)(lds + 8192);
    for (int r0 = blockIdx.x * 64; r0 < M_; r0 += G * 64) {
        const int b = r0 >> 11;
        __syncthreads();
        { const int c = tid * 4; *(LAS f32x4*)(G1 + c) = modv(MODP, b_ada, b, 2, c) * *(const f32x4*)(gp1 + c); *(LAS f32x4*)(G2 + c) = modv(MODP, b_ada, b, 5, c) * *(const f32x4*)(gp2 + c); }
        __syncthreads();
        _Pragma("unroll 1") for (int rr = 0; rr < 8; ++rr) {
            const int row = r0 + wave * 8 + rr; const u32x4* fp = (const u32x4*)(F + (size_t)row * 2048); const u32x4* yp = (const u32x4*)(Y + (size_t)row * 4096);
            const float* xr = x + (size_t)row * 2048; float* xo = OUT + (size_t)row * 2048;
            u32x4 yw[4], fw[4]; float ssy = 0.f, ssf = 0.f;
#pragma unroll
            for (int j = 0; j < 4; ++j) { yw[j] = yp[lane + 64 * j]; fw[j] = __builtin_nontemporal_load(&fp[lane + 64 * j]); }
#pragma unroll
            for (int j = 0; j < 4; ++j) {
                const float y0 = bf_lo(yw[j].x), y1 = bf_hi(yw[j].x), y2 = bf_lo(yw[j].y), y3 = bf_hi(yw[j].y), y4 = bf_lo(yw[j].z), y5 = bf_hi(yw[j].z), y6 = bf_lo(yw[j].w), y7 = bf_hi(yw[j].w);
                ssy += ((y0 * y0 + y1 * y1) + (y2 * y2 + y3 * y3)) + ((y4 * y4 + y5 * y5) + (y6 * y6 + y7 * y7));
                const float f0 = bf_lo(fw[j].x), f1 = bf_hi(fw[j].x), f2 = bf_lo(fw[j].y), f3 = bf_hi(fw[j].y), f4 = bf_lo(fw[j].z), f5 = bf_hi(fw[j].z), f6 = bf_lo(fw[j].w), f7 = bf_hi(fw[j].w);
                ssf += ((f0 * f0 + f1 * f1) + (f2 * f2 + f3 * f3)) + ((f4 * f4 + f5 * f5) + (f6 * f6 + f7 * f7)); }
            const float ry = 1.0f / sqrtf(wave_sum(ssy) * (1.0f / 2048.0f) + EPS_), rf = 1.0f / sqrtf(wave_sum(ssf) * (1.0f / 2048.0f) + EPS_);
#pragma unroll
            for (int j = 0; j < 4; ++j) { const int c = 8 * (lane + 64 * j);
                const f32x4 xa = __builtin_nontemporal_load((const f32x4*)(xr + c)), xb = __builtin_nontemporal_load((const f32x4*)(xr + c + 4));
                const f32x4 g1a = *(const LAS f32x4*)(G1 + c), g1b = *(const LAS f32x4*)(G1 + c + 4), g2a = *(const LAS f32x4*)(G2 + c), g2b = *(const LAS f32x4*)(G2 + c + 4);
                const f32x4 ya = {bf_lo(yw[j].x), bf_hi(yw[j].x), bf_lo(yw[j].y), bf_hi(yw[j].y)}, yb = {bf_lo(yw[j].z), bf_hi(yw[j].z), bf_lo(yw[j].w), bf_hi(yw[j].w)};
                const f32x4 fa = {bf_lo(fw[j].x), bf_hi(fw[j].x), bf_lo(fw[j].y), bf_hi(fw[j].y)}, fb = {bf_lo(fw[j].z), bf_hi(fw[j].z), bf_lo(fw[j].w), bf_hi(fw[j].w)};
                const f32x4 x1a = xa + g1a * ya * ry, x1b = xb + g1b * yb * ry;
                *(f32x4*)(xo + c) = x1a + g2a * fa * rf; *(f32x4*)(xo + c + 4) = x1b + g2b * fb * rf; }
        }
    }
}

#define XB_TMO      128
#define XB_XCNT(j)  (256  + 64 * (j))
#define XB_XSUB(j)  (1280 + 64 * (j))
#define XB_XGEN(j)  (2304 + 64 * (j))
#define XB_TOP      3328
#define XB_TOPGEN   3392
#define XCD_BAR_WORDS 3456
#define XB_SPIN_CAP (1u << 22)
__device__ __forceinline__ unsigned xb_ld(unsigned* p)              { return __hip_atomic_load(p, __ATOMIC_RELAXED, __HIP_MEMORY_SCOPE_AGENT); }
__device__ __forceinline__ unsigned xb_add(unsigned* p, unsigned v) { return __hip_atomic_fetch_add(p, v, __ATOMIC_RELAXED, __HIP_MEMORY_SCOPE_AGENT); }
__device__ __forceinline__ unsigned xb_xcc_id() { return (unsigned)__builtin_amdgcn_s_getreg((3 << 11) | 20) & 0xFu; }
#define XB_SPIN(cond, bar) do { unsigned _sp = 0; while (cond) { __builtin_amdgcn_s_sleep(1); \
    if ((++_sp & 255u) == 0u) { if (xb_ld(&(bar)[XB_TMO])) break; if (_sp > XB_SPIN_CAP) { atomicAdd(&(bar)[XB_TMO], 1u); break; } } } } while (0)
__device__ __forceinline__ void xcd_barrier_complete(unsigned* bar, unsigned x, unsigned G, unsigned& nloc, unsigned& nx) {
    unsigned sum, cnt, mine, sp = 0u;
    for (;;) {
        sum = 0u; cnt = 0u; mine = 0u;
#pragma unroll
        for (unsigned j = 0; j < 16; ++j) { const unsigned c = xb_ld(&bar[XB_XCNT(j)]); sum += c; cnt += (c > 0u) ? 1u : 0u; mine = (j == x) ? c : mine; }
        if (sum == G) break;
        __builtin_amdgcn_s_sleep(1);
        if ((++sp & 255u) == 0u) { if (xb_ld(&bar[XB_TMO])) break; if (sp > XB_SPIN_CAP) { atomicAdd(&bar[XB_TMO], 1u); break; } }
    }
    nloc = mine > 0u ? mine : 1u; nx = cnt > 0u ? cnt : 1u;
}
__device__ __forceinline__ void grid_barrier(unsigned* bar, unsigned x, volatile LAS unsigned* st, unsigned G, int wv) {
    asm volatile("s_waitcnt vmcnt(0) lgkmcnt(0)" ::: "memory");
    __syncthreads();
    int lane; asm volatile("v_mbcnt_lo_u32_b32 %0, -1, 0\n\tv_mbcnt_hi_u32_b32 %0, -1, %0" : "=v"(lane));
    if (wv == 0 && lane == 0) {
        __builtin_amdgcn_s_waitcnt(0);
        unsigned nloc = st[0], nx = st[1];
        if (nloc == 0u) { xcd_barrier_complete(bar, x, G, nloc, nx); st[0] = nloc; st[1] = nx; }
        const unsigned old = xb_add(&bar[XB_XSUB(x)], 1u);
        const unsigned gen = old / nloc;
        if (old + 1u == (gen + 1u) * nloc) {
            __builtin_amdgcn_fence(__ATOMIC_RELEASE, "agent");
            asm volatile("s_waitcnt vmcnt(0)" ::: "memory");
            const unsigned og = xb_add(&bar[XB_TOP], 1u);
            const unsigned tg = og / nx;
            if (og + 1u == (tg + 1u) * nx) xb_add(&bar[XB_TOPGEN], 1u);
            else XB_SPIN(xb_ld(&bar[XB_TOPGEN]) == tg, bar);
            __builtin_amdgcn_fence(__ATOMIC_ACQUIRE, "agent");
            xb_add(&bar[XB_XGEN(x)], 1u);
            asm volatile("s_waitcnt vmcnt(0)" ::: "memory");
        } else {
            XB_SPIN(xb_ld(&bar[XB_XGEN(x)]) == gen, bar);
            __builtin_amdgcn_fence(__ATOMIC_ACQUIRE, "agent");
            asm volatile("s_waitcnt vmcnt(0)" ::: "memory");
        }
    }
    __syncthreads();
}
template <class Epi> __device__ __forceinline__ void run_gemm(LAS unsigned char* lds, const bf16_t* A, const bf16_t* Bt, int N, int K, int lda, int kpairA, const Epi& E, int G, int wv) {
    pg8::Gemm g{A, Bt, M_, N, K, lda, kpairA}; pg8::StaticOrder S; S.init(M_, N, G, (int)blockIdx.x);
    pg8::gemm_phase<Epi, pg8::StaticOrder, true, true>(lds, g, S, E, wv);
}
constexpr int NPHASE = 13;
__global__ void __launch_bounds__(512) fwd_kernel(Args a) {
    extern __shared__ __attribute__((aligned(16))) unsigned char lds_raw[];
    LAS unsigned char* lds = (LAS unsigned char*)lds_raw;
    cg::grid_group grid = cg::this_grid();
    const int G = gridDim.x, lo = a.ph_lo, hi = a.ph_hi, wv = __builtin_amdgcn_readfirstlane((int)threadIdx.x >> 6);
    unsigned char* ws = a.ws;
#ifndef REPEAT_MASK
#define REPEAT_MASK 0
#endif
#define REP(k) ((REPEAT_MASK >> (k)) & 1)
#ifndef PH_MASK
#define PH_MASK 0x1fff
#endif
#define IN(k) (lo <= (k) && (k) < hi && ((PH_MASK >> (k)) & 1))
#define SEAM(k) do { if (IN(k) && IN((k) + 1)) { grid_barrier((unsigned*)ws, xcc, bst, (unsigned)G, wv); } } while (0)
    volatile LAS unsigned* bst = (volatile LAS unsigned*)(lds + LDS_BYTES - 16);
    const unsigned xcc = xb_xcc_id();
    if (threadIdx.x == 0) { bst[0] = 0u; bst[1] = 0u; (void)xb_add(&((unsigned*)ws)[XB_XCNT(xcc)], 1u); }
    __syncthreads();
    if (lo < 0) grid.sync();
    if (IN(0)) for (int rep_ = 0; rep_ <= REP(0); ++rep_) { __syncthreads(); phase0(a, lds, G, wv); }
    SEAM(0);
    if (IN(1)) for (int rep_ = 0; rep_ <= REP(1); ++rep_) { __syncthreads(); phase1(a, lds, G, wv); }
    SEAM(1);
    if (IN(2)) for (int rep_ = 0; rep_ <= REP(2); ++rep_) { __syncthreads(); pg8::EpiIn E{(bf16_t*)(ws + WS_D), (bf16_t*)(ws + WS_E), (bf16_t*)(ws + WS_F), (bf16_t*)(ws + WS_G), (bf16_t*)(ws + WS_QL), (bf16_t*)(ws + WS_KVL), (bf16_t*)(ws + WS_KPE),
            (float*)(ws + WS_STAT), (float*)(ws + WS_STAT) + 2 * M_, (float*)(ws + WS_STAT) + 3 * M_, (const float*)(ws + WS_COS), (const float*)(ws + WS_SIN)};
        run_gemm(lds, (const bf16_t*)a.out, (const bf16_t*)(ws + WS_WIN), 9216, 2048, 2048, 256, E, G, wv); }
    SEAM(2);
    if (IN(4)) {
        if (REP(13)) mix_phase(a, lds, G, wv, WS_KN);
        mix_phase(a, lds, G, wv);
        for (int rep_ = 0; rep_ <= REP(4); ++rep_) {
        { pg8::EpiBf16 E{(bf16_t*)a.out, 3072, QSCALE, (const float*)(ws + WS_STAT) + 2 * M_, 1.0f / 512.0f}; run_gemm(lds, (const bf16_t*)(ws + WS_QL), (const bf16_t*)(ws + WS_WUQ), 3072, 512, 512, 256, E, G, wv); }
        __syncthreads();
        { pg8::EpiKV E{(bf16_t*)(ws + WS_KN), (bf16_t*)(ws + WS_VT), (const float*)(ws + WS_STAT) + 3 * M_}; run_gemm(lds, (const bf16_t*)(ws + WS_KVL), (const bf16_t*)(ws + WS_WUKV), 4096, 256, 256, 256, E, G, wv); }
        __syncthreads(); }
    }
    SEAM(4);
    if (IN(5)) {
        for (int rep_ = 0; rep_ <= REP(5); ++rep_) attn_phase(a, lds, G, wv);
        __syncthreads();
        { pg8::EpiMulInPlace E{(bf16_t*)(ws + WS_F)}; run_gemm(lds, (const bf16_t*)(ws + WS_D), (const bf16_t*)(ws + WS_WA), 2048, 2048, 2048, 256, E, G, wv); }
    }
    SEAM(5);
    if (IN(6)) { pg8::EpiMerge E{(bf16_t*)(ws + WS_F), (const bf16_t*)(ws + WS_G)}; run_gemm(lds, (const bf16_t*)(ws + WS_E), (const bf16_t*)(ws + WS_WB), 2048, 2048, 2048, 256, E, G, wv); }
    SEAM(6);
    if (IN(7)) for (int rep_ = 0; rep_ <= REP(7); ++rep_) { __syncthreads(); pg8::EpiBf16 E{(bf16_t*)a.out, 4096, 1.0f, nullptr, 0.f};   run_gemm(lds, (const bf16_t*)(ws + WS_F), (const bf16_t*)(ws + WS_WOUT), 2048, 2048, 2048, 256, E, G, wv); }
    SEAM(7);
    if (IN(8)) { if (REP(8)) { phase8(a, lds, G, wv, WS_E); __syncthreads(); } phase8(a, lds, G, wv); }
    SEAM(8);
    if (IN(9)) for (int rep_ = 0; rep_ <= REP(9); ++rep_) { __syncthreads(); pg8::EpiUp E{(bf16_t*)(ws + WS_UP), (bf16_t*)(ws + WS_HALO)}; run_gemm(lds, (const bf16_t*)(ws + WS_D), (const bf16_t*)(ws + WS_WUP), 11264, 2048, 2048, 256, E, G, wv); }
    SEAM(9);
    if (IN(10)) { if (REP(10)) { phase10(a, G, wv, true); __syncthreads(); } phase10(a, G, wv); }
    SEAM(10);
    if (IN(11)) for (int rep_ = 0; rep_ <= REP(11); ++rep_) { __syncthreads(); pg8::EpiBf16 E{(bf16_t*)(ws + WS_D), 2048, 1.0f, nullptr, 0.f}; run_gemm(lds, (const bf16_t*)(ws + WS_UP), (const bf16_t*)(ws + WS_WDOWN), 2048, 5632, 5632, 256, E, G, wv); }
    SEAM(11);
    if (IN(12)) { if (REP(12)) { phase12(a, lds, G, wv, (float*)(ws + WS_UP)); __syncthreads(); } phase12(a, lds, G, wv); }
#undef IN
#undef SEAM
}

extern "C" void kernel_launch(void* const* d_in, const int* in_sizes, int n_in, void* d_out, int out_size, void* d_ws, size_t ws_size, hipStream_t stream) {
    static int grid = 0;
    if (grid == 0) {
        int dev = 0, cus = 0, per_cu = 0;
        hipGetDevice(&dev); hipDeviceGetAttribute(&cus, hipDeviceAttributeMultiprocessorCount, dev);
        if (hipFuncSetAttribute((const void*)fwd_kernel, hipFuncAttributeMaxDynamicSharedMemorySize, LDS_BYTES) != hipSuccess) fprintf(stderr, "kernel_launch: hipFuncSetAttribute failed\n");
        if (hipOccupancyMaxActiveBlocksPerMultiprocessor(&per_cu, (const void*)fwd_kernel, 512, LDS_BYTES) != hipSuccess || per_cu < 1) { fprintf(stderr, "kernel_launch: occupancy query says %d\n", per_cu); per_cu = 1; }
        (void)hipGetLastError();
        if (cus <= 0) cus = 256;
        grid = cus * per_cu;
        if (ws_size < 512 * MiB) fprintf(stderr, "kernel_launch: workspace too small: %zu\n", ws_size);
    }
    if (hipMemsetAsync(d_ws, 0, 16384, stream) != hipSuccess) fprintf(stderr, "kernel_launch: memset failed\n");
    Args a{};
    for (int i = 0; i < 25; ++i) a.in[i] = d_in[i];
    a.out = (float*)d_out; a.ws = (unsigned char*)d_ws;
    for (int i = 0; i < 32; ++i) a.inv[i] = (float)std::pow(10000.0, -(double)i / 32.0);
#if MK_LAUNCHES == 1
    a.ph_lo = 0; a.ph_hi = NPHASE;
    void* args[] = {&a};
    hipError_t e = hipLaunchCooperativeKernel((const void*)fwd_kernel, dim3(grid), dim3(512), args, LDS_BYTES, stream);
    if (e != hipSuccess) fprintf(stderr, "cooperative launch failed: %s (grid %d)\n", hipGetErrorString(e), grid);
#else
    for (int p = 0; p < NPHASE; ++p) { a.ph_lo = p; a.ph_hi = p + 1; hipLaunchKernelGGL(fwd_kernel, dim3(grid), dim3(512), LDS_BYTES, stream, a); }
#endif
}
```
